# Optimizing an MI355X kernel written in HIP

```python
import jax, jax.numpy as jnp
from jax import lax
import numpy as np

D_MODEL = 1024
BATCH = 4
SEQ = 4096
DEPTH = 1

N_META = 16
GRID_W = 64
M_HEADS = 4
M_DV = 256
M_DK = 128
M_INNER = M_HEADS * M_DV
M_CONV = 3
M_CHUNK = 64
NA_HEADS = 8
NA_DH = 64
NA_INNER = NA_HEADS * NA_DH
NA_WIN_H_MAX = 8
NA_WIN_W = 16
NA_SEG_W = NA_WIN_W
NA_REGION_W = 2 * NA_WIN_W
N_BRANCH = 2
D_FF = 4 * D_MODEL
EPS = 1e-6
NEG_LOG_GATE = -1e9
OFF_MX = 0
OFF_MO = OFF_MX + M_INNER
OFF_MG = OFF_MO + M_INNER
OFF_Q = OFF_MG + 4 * M_HEADS
OFF_K = OFF_Q + NA_INNER
OFF_V = OFF_K + NA_INNER
OFF_G = OFF_V + NA_INNER
D_IN_PROJ = OFF_G + N_BRANCH * D_MODEL

kernel_name = "hybrid_mlstm_natten_block"


def rms_norm(x, g):
    xf = x.astype(jnp.float32)
    y = xf * lax.rsqrt(jnp.mean(jnp.square(xf), axis=-1, keepdims=True) + EPS)
    return (y * g.astype(jnp.float32)).astype(x.dtype)


def centred_depthwise_conv(x, w):
    k = w.shape[0]
    return lax.conv_general_dilated(x, w.astype(x.dtype), (1,), [(k // 2, k // 2)],
                                    dimension_numbers=('NWC', 'WIO', 'NWC'),
                                    feature_group_count=x.shape[-1])


def mlstm_chunkwise(q, k, v, log_i, log_f):
    B, H, Lp, dk = q.shape
    dv = v.shape[-1]
    nc = Lp // M_CHUNK
    chunk = lambda a: jnp.moveaxis(a.reshape(B, H, nc, M_CHUNK, *a.shape[3:]), 2, 0)
    causal = jnp.tril(jnp.ones((M_CHUNK, M_CHUNK), dtype=bool))

    def step(carry, inp):
        C, n, m = carry
        qt, kt, vt, li, lf = inp
        b = jnp.cumsum(lf, axis=-1)
        d = jnp.where(causal, b[..., :, None] - b[..., None, :] + li[..., None, :], -jnp.inf)
        m_inter = b + m[..., None]
        m_t = jnp.maximum(m_inter, jnp.max(d, axis=-1))
        w_inter = jnp.exp(m_inter - m_t)
        s = jnp.einsum('bhtd,bhsd->bhts', qt, kt) * jnp.exp(d - m_t[..., None])
        num = w_inter[..., None] * jnp.einsum('bhtd,bhde->bhte', qt, C) + jnp.einsum('bhts,bhse->bhte', s, vt)
        den = w_inter * jnp.einsum('bhtd,bhd->bht', qt, n) + jnp.sum(s, axis=-1)
        h = num / jnp.maximum(jnp.abs(den), jnp.exp(-m_t))[..., None]
        b_end = b[..., -1]
        a = b_end[..., None] - b + li
        m_new = jnp.maximum(b_end + m, jnp.max(a, axis=-1))
        decay = jnp.exp(b_end + m - m_new)
        kw = kt * jnp.exp(a - m_new[..., None])[..., None]
        C_new = decay[..., None, None] * C + jnp.einsum('bhsd,bhse->bhde', kw, vt)
        n_new = decay[..., None] * n + jnp.sum(kw, axis=2)
        return (C_new, n_new, m_new), h

    init = (jnp.zeros((B, H, dk, dv), jnp.float32), jnp.zeros((B, H, dk), jnp.float32),
            jnp.zeros((B, H), jnp.float32))
    _, hs = lax.scan(step, init, (chunk(q), chunk(k), chunk(v), chunk(log_i), chunk(log_f)))
    return jnp.moveaxis(hs, 0, 2).reshape(B, H, Lp, dv)


def mlstm_bidirectional(q, k, v, gates):
    n_pad = M_CHUNK - N_META
    pad_t = lambda a: jnp.pad(a, ((0, 0), (0, 0), (n_pad, 0), (0, 0)))
    qp, kp, vp = pad_t(q), pad_t(k), pad_t(v)
    g = jnp.transpose(gates, (0, 2, 3, 1))
    pad_g = lambda a, c: jnp.pad(a, ((0, 0), (0, 0), (n_pad, 0)), constant_values=c)
    li_f = pad_g(g[:, 0], NEG_LOG_GATE)
    lf_f = pad_g(jax.nn.log_sigmoid(g[:, 1]), 0.0)
    li_b = pad_g(g[:, 2], NEG_LOG_GATE)
    lf_b = pad_g(jax.nn.log_sigmoid(g[:, 3]), 0.0)
    h_f = mlstm_chunkwise(qp, kp, vp, li_f, lf_f)
    ft = lambda a: jnp.flip(a, axis=2)
    h_b = ft(mlstm_chunkwise(ft(qp), ft(kp), ft(vp), jnp.flip(li_b, -1), jnp.flip(lf_b, -1)))
    return (h_f + h_b)[:, :, n_pad:]


def neighbourhood_attention(q, k, v, rpb, meta_bias, rows):
    B, H, _, dh = q.shape
    qm, km, vm = q[:, :, :N_META], k[:, :, :N_META], v[:, :, :N_META]
    qr, kr, vr = q[:, :, N_META:], k[:, :, N_META:], v[:, :, N_META:]
    wh = min(NA_WIN_H_MAX, rows)
    n_seg = GRID_W // NA_SEG_W
    nk = wh * NA_REGION_W
    seg = jnp.arange(n_seg)
    qcols = seg[:, None] * NA_SEG_W + jnp.arange(NA_SEG_W)[None, :]
    reg0 = jnp.clip(seg * NA_SEG_W - NA_WIN_W // 2, 0, GRID_W - NA_REGION_W)
    kcols = reg0[:, None] + jnp.arange(NA_REGION_W)[None, :]
    win0 = jnp.clip(qcols - NA_WIN_W // 2, 0, GRID_W - NA_WIN_W)
    col_ok = (kcols[:, None, :] >= win0[..., None]) & (kcols[:, None, :] < win0[..., None] + NA_WIN_W)
    mask = jnp.broadcast_to(col_ok[:, :, None, :], (n_seg, NA_SEG_W, wh, NA_REGION_W)).reshape(n_seg, NA_SEG_W, nk)
    dc = jnp.clip(kcols[:, None, :] - qcols[..., None], -(NA_WIN_W - 1), NA_WIN_W - 1) + NA_WIN_W - 1
    mb = meta_bias.astype(jnp.float32)

    def row_block(r):
        r0 = jnp.clip(r - wh // 2, 0, rows - wh)
        krows = r0 + jnp.arange(wh)
        dr = krows - r + NA_WIN_H_MAX - 1
        bias = rpb[:, dr[None, None, :, None], dc[:, :, None, :]].reshape(H, n_seg, NA_SEG_W, nk)
        kidx = (krows[None, :, None] * GRID_W + kcols[:, None, :]).reshape(-1)
        qidx = (r * GRID_W + qcols).reshape(-1)
        qb = jnp.take(qr, qidx, axis=2).reshape(B, H, n_seg, NA_SEG_W, dh)
        kb = jnp.take(kr, kidx, axis=2).reshape(B, H, n_seg, nk, dh)
        vb = jnp.take(vr, kidx, axis=2).reshape(B, H, n_seg, nk, dh)
        s_loc = jnp.einsum('bhnqd,bhnkd->bhnqk', qb, kb).astype(jnp.float32) + bias.astype(jnp.float32)
        s_loc = jnp.where(mask, s_loc, -jnp.inf)
        s_met = jnp.einsum('bhnqd,bhmd->bhnqm', qb, km).astype(jnp.float32) + mb[:, None, None, :]
        p = jax.nn.softmax(jnp.concatenate([s_loc, s_met], axis=-1), axis=-1).astype(v.dtype)
        return (jnp.einsum('bhnqk,bhnkd->bhnqd', p[..., :nk], vb)
                + jnp.einsum('bhnqm,bhmd->bhnqd', p[..., nk:], vm))

    o_r = lax.map(row_block, jnp.arange(rows))
    o_r = jnp.moveaxis(o_r, 0, 2).reshape(B, H, rows * GRID_W, dh)
    s_mm = jnp.einsum('bhqd,bhmd->bhqm', qm, km).astype(jnp.float32) + mb[:, None, :]
    o_m = jnp.einsum('bhqm,bhmd->bhqd', jax.nn.softmax(s_mm, axis=-1).astype(v.dtype), vm)
    return jnp.concatenate([o_m, o_r], axis=2)


def setup_inputs(seed: int = 0) -> dict:
    key = jax.random.key(seed)
    ks = jax.random.split(key, 24)
    nrm = lambda kk, shape, scale: jax.random.normal(kk, shape, jnp.float32) * scale
    f_bias = jnp.linspace(3.0, 6.0, M_HEADS, dtype=jnp.float32)
    gate_b = jnp.stack([nrm(ks[6], (M_HEADS,), 0.1),
                        f_bias + nrm(ks[7], (M_HEADS,), 0.1),
                        nrm(ks[8], (M_HEADS,), 0.1),
                        f_bias + nrm(ks[9], (M_HEADS,), 0.1)])
    return {
        'x': nrm(ks[0], (BATCH, SEQ, D_MODEL), 1.0),
        'meta_tokens': nrm(ks[1], (N_META, D_MODEL), 1.0),
        'norm1_g': 1.0 + nrm(ks[2], (D_MODEL,), 0.02),
        'w_in': nrm(ks[3], (D_MODEL, D_IN_PROJ), D_MODEL ** -0.5),
        'mlstm_conv_w': nrm(ks[4], (M_CONV, 1, M_INNER), M_CONV ** -0.5),
        'mlstm_conv_b': nrm(ks[5], (M_INNER,), 0.02),
        'mlstm_wq': nrm(ks[10], (M_HEADS, M_DV, M_DK), M_DV ** -0.5),
        'mlstm_wk': nrm(ks[11], (M_HEADS, M_DV, M_DK), M_DV ** -0.5),
        'mlstm_gate_b': gate_b,
        'mlstm_norm_g': 1.0 + nrm(ks[12], (M_HEADS, M_DV), 0.02),
        'mlstm_skip': 1.0 + nrm(ks[13], (M_INNER,), 0.02),
        'na_q_norm_g': 1.0 + nrm(ks[14], (NA_DH,), 0.02),
        'na_k_norm_g': 1.0 + nrm(ks[15], (NA_DH,), 0.02),
        'na_rpb': nrm(ks[16], (NA_HEADS, 2 * NA_WIN_H_MAX - 1, 2 * NA_WIN_W - 1), 0.02),
        'na_meta_bias': nrm(ks[17], (NA_HEADS, N_META), 0.02),
        'w_branch_a': nrm(ks[18], (M_INNER, D_MODEL), M_INNER ** -0.5),
        'w_branch_b': nrm(ks[19], (NA_INNER, D_MODEL), NA_INNER ** -0.5),
        'w_out': nrm(ks[20], (D_MODEL, D_MODEL), D_MODEL ** -0.5),
        'norm2_g': 1.0 + nrm(ks[21], (D_MODEL,), 0.02),
        'w_ff1': nrm(ks[22], (D_MODEL, D_FF), D_MODEL ** -0.5),
        'w_ff2': nrm(ks[23], (D_FF, D_MODEL), D_FF ** -0.5),
    }


def reference(x, meta_tokens, norm1_g, w_in, mlstm_conv_w, mlstm_conv_b, mlstm_wq, mlstm_wk,
              mlstm_gate_b, mlstm_norm_g, mlstm_skip, na_q_norm_g, na_k_norm_g, na_rpb, na_meta_bias,
              w_branch_a, w_branch_b, w_out, norm2_g, w_ff1, w_ff2):
    B, S, D = x.shape
    rows = S // GRID_W
    L = N_META + S
    h = jnp.concatenate([jnp.broadcast_to(meta_tokens[None].astype(x.dtype), (B, N_META, D)), x], axis=1)
    for _ in range(DEPTH):
        xn = rms_norm(h, norm1_g)
        u = xn @ w_in
        xm = u[..., OFF_MX:OFF_MO]
        xc = jax.nn.silu(centred_depthwise_conv(xm, mlstm_conv_w) + mlstm_conv_b)
        xch = xc.reshape(B, L, M_HEADS, M_DV)
        q_m = jnp.einsum('blhe,hed->bhld', xch, mlstm_wq).astype(jnp.float32)
        k_m = jnp.einsum('blhe,hed->bhld', xch, mlstm_wk).astype(jnp.float32) * (M_DK ** -0.5)
        v_m = xm.reshape(B, L, M_HEADS, M_DV).transpose(0, 2, 1, 3).astype(jnp.float32)
        gates = (u[..., OFF_MG:OFF_Q].reshape(B, L, 4, M_HEADS) + mlstm_gate_b).astype(jnp.float32)
        h_m = mlstm_bidirectional(q_m, k_m, v_m, gates)
        h_m = h_m * lax.rsqrt(jnp.mean(jnp.square(h_m), axis=-1, keepdims=True) + EPS)
        h_m = h_m * mlstm_norm_g.astype(jnp.float32)[None, :, None, :]
        h_m = h_m.transpose(0, 2, 1, 3).reshape(B, L, M_INNER).astype(x.dtype)
        y_a = jax.nn.sigmoid(u[..., OFF_MO:OFF_MG]) * (h_m + mlstm_skip * xc)
        q_n = rms_norm(u[..., OFF_Q:OFF_K].reshape(B, L, NA_HEADS, NA_DH), na_q_norm_g).transpose(0, 2, 1, 3) * (NA_DH ** -0.5)
        k_n = rms_norm(u[..., OFF_K:OFF_V].reshape(B, L, NA_HEADS, NA_DH), na_k_norm_g).transpose(0, 2, 1, 3)
        v_n = u[..., OFF_V:OFF_G].reshape(B, L, NA_HEADS, NA_DH).transpose(0, 2, 1, 3)
        o_n = neighbourhood_attention(q_n, k_n, v_n, na_rpb, na_meta_bias, rows)
        y_b = o_n.transpose(0, 2, 1, 3).reshape(B, L, NA_INNER)
        g_a = jax.nn.sigmoid(u[..., OFF_G:OFF_G + D_MODEL])
        g_b = jax.nn.sigmoid(u[..., OFF_G + D_MODEL:OFF_G + 2 * D_MODEL])
        mix = g_a * (y_a @ w_branch_a) + g_b * (y_b @ w_branch_b)
        h = h + mix @ w_out
        z = rms_norm(h, norm2_g) @ w_ff1
        h = h + jnp.square(jax.nn.relu(z)) @ w_ff2
    return h[:, N_META:]
```

```cpp
#include <hip/hip_runtime.h>
#include <cstdio>
#include <cstdint>

namespace pg8 {
#define PG8_LAS __attribute__((address_space(3)))
typedef unsigned short bf16_t;
typedef short bf16x8 __attribute__((ext_vector_type(8)));
typedef float f32x4 __attribute__((ext_vector_type(4)));
typedef unsigned u32x4 __attribute__((ext_vector_type(4)));
typedef unsigned u32x2 __attribute__((ext_vector_type(2)));
constexpr int BM = 256, BK = 64, HALF = 128, HTB = HALF * BK * 2  , STAGE_BYTES = 8 * HTB, NXCD = 8, WGM = 8;

__host__ __device__ __forceinline__ int lds_byte(int r, int c) { const int st = (r >> 4) * 2 + (c >> 5), rr = r & 15, cc = c & 31, ob = rr * 64 + cc * 2; return st * 1024 + (ob ^ (((ob >> 9) & 1) << 5)); }
__host__ __device__ __forceinline__ void stage_rc(int b, int& R, int& C) { const int st = b / 1024, sb = b % 1024, swz = sb ^ (((sb >> 9) & 1) << 5); R = (st >> 1) * 16 + swz / 64; C = (st & 1) * 32 + (swz % 64) / 2; }
__host__ __device__ __forceinline__ int perm32(int rho) { const int n = rho >> 4, i = rho & 15; return 8 * (i >> 2) + 4 * n + (i & 3); }

struct Unit { int pm, pn; };
struct Gemm { const bf16_t* A; const bf16_t* Bt; int K, lda, ldb, a_pn_cols; const bf16_t* A1; const bf16_t* A2; int plane_tiles; };

struct StaticOrder {
    int nM, nN, nwg, G, c;
    __host__ __device__ void init(int M, int N, int G_, int c_) { nM = M / BM; nN = N / BM; nwg = nM * nN; G = G_; c = c_; }
    __host__ __device__ bool next(int i, Unit& u) const {
        const long L = (long)i * G + c; if (L >= nwg) return false;
        int wgid = (int)L; { const int q = nwg / NXCD, r = nwg % NXCD, xcd = wgid % NXCD, off = wgid / NXCD; wgid = (xcd < r ? xcd * (q + 1) : r * (q + 1) + (xcd - r) * q) + off; }
        const int nig = WGM * nN, gid = wgid / nig, fm = gid * WGM, gsz = (nM - fm) < WGM ? (nM - fm) : WGM;
        u.pm = fm + ((wgid % nig) % gsz); u.pn = (wgid % nig) / gsz; return true;
    }
};

typedef float f32x2_t __attribute__((ext_vector_type(2))); typedef __bf16 bf16x2_t __attribute__((ext_vector_type(2)));
__device__ __forceinline__ unsigned cvt_pk_safe(float lo, float hi) { f32x2_t v = {lo, hi}; bf16x2_t b = __builtin_convertvector(v, bf16x2_t); return __builtin_bit_cast(unsigned, b); }
__device__ __forceinline__ unsigned cvt_pk_bf16(float lo, float hi) { unsigned r; asm volatile("v_cvt_pk_bf16_f32 %0, %1, %2" : "=v"(r) : "v"(lo), "v"(hi)); return r; }

template <class Epi, class Sched, bool ALIGN_EPI = false, bool SP2 = false>
__device__ __forceinline__ void gemm_phase(PG8_LAS unsigned char* lds, const Gemm g, const Sched& S, const Epi& E) {
    const int tid = threadIdx.x, wid = __builtin_amdgcn_readfirstlane(tid >> 6), lane = tid & 63, wr = wid >> 2, wc = wid & 3, fr = lane & 15, fq = lane >> 4;
    const int K = g.K, nt = K / BK;
    unsigned voffA[2], voffB[2];
#pragma unroll
    for (int i = 0; i < 2; ++i) { int R, C; stage_rc(tid * 16 + i * 8192, R, C); const int Rb = Epi::PERM ? ((R & ~31) + perm32(R & 31)) : R;
        voffA[i] = (unsigned)(R * g.lda + C) * 2u; voffB[i] = (unsigned)(Rb * g.ldb + C) * 2u; }
    const size_t kstep = (size_t)(BK * 2);
    const size_t hstepA = (size_t)HALF * g.lda * 2, hstepB = (size_t)HALF * g.ldb * 2;
    const size_t tstepA = 2 * hstepA, tstepB = 2 * hstepB;
    const size_t pnA = (size_t)g.a_pn_cols * 2;
    const unsigned ldsw = (unsigned)wid * 1024u;
    const int aoff = lds_byte(wr * 64 + fr, fq * 8), boff = lds_byte(wc * 32 + fr, fq * 8);
#define PG8_SA(b, h) (((b) * 2 + (h)) * HTB)
#define PG8_SB(b, h) ((4 + (b) * 2 + (h)) * HTB)
#define PG8_STAGE(bufoff, gbase, voff) do { _Pragma("unroll") for (int _i = 0; _i < 2; ++_i) \
        __builtin_amdgcn_global_load_lds((const unsigned*)((const char*)(gbase) + (voff)[_i]), (PG8_LAS unsigned*)(lds + (bufoff) + ldsw + _i * 8192), 16, 0, 0); } while (0)
#define PG8_LDA(dst, b, h) do { _Pragma("unroll") for (int m = 0; m < 4; ++m) _Pragma("unroll") for (int k = 0; k < 2; ++k) dst[m][k] = *(const PG8_LAS bf16x8*)(lds + PG8_SA(b, h) + aoff + m * 2048 + k * 1024); } while (0)
#define PG8_LDB(dst, b, h) do { _Pragma("unroll") for (int n = 0; n < 2; ++n) _Pragma("unroll") for (int k = 0; k < 2; ++k) dst[n][k] = *(const PG8_LAS bf16x8*)(lds + PG8_SB(b, h) + boff + n * 2048 + k * 1024); } while (0)
#define PG8_MMA(ai, bj, At, Bt) do { __builtin_amdgcn_s_setprio(1); _Pragma("unroll") for (int m = 0; m < 4; ++m) _Pragma("unroll") for (int n = 0; n < 2; ++n) _Pragma("unroll") for (int k = 0; k < 2; ++k) \
        acc[ai][bj][m][n] = __builtin_amdgcn_mfma_f32_16x16x32_bf16(Bt[n][k], At[m][k], acc[ai][bj][m][n], 0, 0, 0); __builtin_amdgcn_s_setprio(0); } while (0)
#define PG8_WAIT_V(n) asm volatile("s_waitcnt vmcnt(" #n ")" ::: "memory")
#define PG8_WAIT_L(n) asm volatile("s_waitcnt lgkmcnt(" #n ")" ::: "memory")
#define PG8_BAR __builtin_amdgcn_s_barrier()
#define PG8_SCHED __builtin_amdgcn_sched_barrier(0)
    Unit cur, nxt; int ui = 0;
    if (!S.next(0, cur)) return;
    f32x4 acc[2][2][4][2];
#pragma unroll
    for (int a = 0; a < 2; ++a)
#pragma unroll
        for (int b = 0; b < 2; ++b)
#pragma unroll
            for (int m = 0; m < 4; ++m)
#pragma unroll
                for (int n = 0; n < 2; ++n) acc[a][b][m][n] = (f32x4){0.f, 0.f, 0.f, 0.f};
    bf16x8 At[4][2], B0[2][2], B1[2][2];
    const int pt = g.plane_tiles; const long long pj1 = (const char*)g.A1 - (const char*)g.A - (long long)pt * (long long)kstep, pj2 = (const char*)g.A2 - (const char*)g.A - 2ll * pt * (long long)kstep;
#define PG8_AT(base, t) ((base) + (size_t)(t) * kstep + (((t) >= pt) ? (((t) >= 2 * pt) ? pj2 : pj1) : 0ll))
    const char* cA = (const char*)g.A + (size_t)cur.pm * tstepA + (size_t)cur.pn * pnA; const char* cB = (const char*)g.Bt + (size_t)cur.pn * tstepB;
    if constexpr (SP2) {
        PG8_STAGE(PG8_SB(0, 0), cB, voffB); PG8_STAGE(PG8_SB(0, 1), cB + hstepB, voffB); PG8_STAGE(PG8_SA(0, 0), cA, voffA); PG8_STAGE(PG8_SA(0, 1), cA + hstepA, voffA);
        if (wr == 1) PG8_BAR;
        PG8_WAIT_V(2); PG8_BAR;
        PG8_STAGE(PG8_SB(1, 0), cB + kstep, voffB); PG8_STAGE(PG8_SA(1, 0), cA + kstep, voffA); PG8_STAGE(PG8_SB(1, 1), cB + hstepB + kstep, voffB);
        PG8_WAIT_V(6); PG8_BAR;
    } else {
        PG8_STAGE(PG8_SB(0, 0), cB, voffB); PG8_STAGE(PG8_SA(0, 0), cA, voffA); PG8_STAGE(PG8_SB(0, 1), cB + hstepB, voffB); PG8_STAGE(PG8_SA(0, 1), cA + hstepA, voffA);
        if (wr == 1) PG8_BAR;
        PG8_WAIT_V(4); PG8_BAR;
        PG8_STAGE(PG8_SB(1, 0), cB + kstep, voffB); PG8_STAGE(PG8_SA(1, 0), cA + kstep, voffA); PG8_STAGE(PG8_SB(1, 1), cB + hstepB + kstep, voffB);
        PG8_WAIT_V(6); PG8_BAR;
    }
    for (;;) {
        const bool has_next = S.next(ui + 1, nxt);
        const char* nA = has_next ? (const char*)g.A + (size_t)nxt.pm * tstepA + (size_t)nxt.pn * pnA : cA; const char* nB = has_next ? (const char*)g.Bt + (size_t)nxt.pn * tstepB : cB;
        for (int t = 0; t < nt; t += 2) {
            const bool last = (t == nt - 2);
            if constexpr (Epi::MID_T >= 0) { if (t == Epi::MID_T) E.mid(acc, cur, wr, wc, fr, fq); }
            const char* a1 = PG8_AT(cA, t + 1);
            const char* a2 = last ? nA : PG8_AT(cA, t + 2); const char* b2 = last ? nB : cB + (size_t)(t + 2) * kstep;
            const char* a3 = a2 + kstep; const char* b3 = b2 + kstep;
            if constexpr (SP2) {
            PG8_LDB(B0, 0, 0); PG8_LDB(B1, 0, 1); PG8_SCHED; PG8_LDA(At, 0, 0); PG8_STAGE(PG8_SA(1, 1), a1 + hstepA, voffA);
            PG8_WAIT_V(8); PG8_WAIT_L(0); PG8_BAR; PG8_MMA(0, 0, At, B0); PG8_MMA(0, 1, At, B1); PG8_BAR; PG8_SCHED;
            PG8_LDA(At, 0, 1); PG8_STAGE(PG8_SB(0, 0), b2, voffB); PG8_STAGE(PG8_SB(0, 1), b2 + hstepB, voffB); PG8_STAGE(PG8_SA(0, 0), a2, voffA);
            PG8_WAIT_V(8); PG8_WAIT_L(0); PG8_BAR; PG8_MMA(1, 0, At, B0); PG8_MMA(1, 1, At, B1); PG8_BAR; PG8_SCHED;
            PG8_LDB(B0, 1, 0); PG8_LDB(B1, 1, 1); PG8_SCHED; PG8_LDA(At, 1, 0); PG8_STAGE(PG8_SA(0, 1), a2 + hstepA, voffA);
            PG8_WAIT_V(8); PG8_WAIT_L(0); PG8_BAR; PG8_MMA(0, 0, At, B0); PG8_MMA(0, 1, At, B1); PG8_BAR; PG8_SCHED;
            PG8_LDA(At, 1, 1); PG8_STAGE(PG8_SB(1, 0), b3, voffB); PG8_STAGE(PG8_SB(1, 1), b3 + hstepB, voffB); PG8_STAGE(PG8_SA(1, 0), a3, voffA);
            PG8_WAIT_V(8); PG8_WAIT_L(0); PG8_BAR; PG8_MMA(1, 0, At, B0); PG8_MMA(1, 1, At, B1); PG8_BAR; PG8_SCHED;
            } else {
            PG8_LDB(B0, 0, 0); PG8_SCHED; PG8_LDA(At, 0, 0); PG8_STAGE(PG8_SA(1, 1), a1 + hstepA, voffA);
            PG8_WAIT_L(8); PG8_BAR; PG8_WAIT_L(0); PG8_MMA(0, 0, At, B0); PG8_BAR; PG8_SCHED;
            PG8_LDB(B1, 0, 1); PG8_STAGE(PG8_SB(0, 0), b2, voffB);
            PG8_BAR; PG8_WAIT_L(0); PG8_MMA(0, 1, At, B1); PG8_BAR;
            PG8_LDA(At, 0, 1); PG8_STAGE(PG8_SA(0, 0), a2, voffA);
            PG8_BAR; PG8_WAIT_L(0); PG8_MMA(1, 0, At, B0); PG8_BAR; PG8_SCHED;
            PG8_STAGE(PG8_SB(0, 1), b2 + hstepB, voffB);
            PG8_WAIT_V(6); PG8_BAR; PG8_MMA(1, 1, At, B1); PG8_BAR;
            PG8_LDB(B0, 1, 0); PG8_SCHED; PG8_LDA(At, 1, 0); PG8_STAGE(PG8_SA(0, 1), a2 + hstepA, voffA);
            PG8_WAIT_L(8); PG8_BAR; PG8_WAIT_L(0); PG8_MMA(0, 0, At, B0); PG8_BAR; PG8_SCHED;
            PG8_LDB(B1, 1, 1); PG8_STAGE(PG8_SB(1, 0), b3, voffB);
            PG8_BAR; PG8_WAIT_L(0); PG8_MMA(0, 1, At, B1); PG8_BAR;
            PG8_LDA(At, 1, 1); PG8_STAGE(PG8_SA(1, 0), a3, voffA);
            PG8_BAR; PG8_WAIT_L(0); PG8_MMA(1, 0, At, B0); PG8_BAR; PG8_SCHED;
            PG8_STAGE(PG8_SB(1, 1), b3 + hstepB, voffB);
            PG8_WAIT_V(6); PG8_BAR; PG8_MMA(1, 1, At, B1); PG8_BAR;
            }
        }
        if constexpr (ALIGN_EPI) { if (wr == 0) PG8_BAR; }
        { int t2 = threadIdx.x; asm volatile("" : "+v"(t2)); const int l2 = t2 & 63;
          E(acc, cur, wr, wc, l2 & 15, l2 >> 4); }
        if (!has_next) break;
#pragma unroll
        for (int a = 0; a < 2; ++a)
#pragma unroll
            for (int b = 0; b < 2; ++b)
#pragma unroll
                for (int m = 0; m < 4; ++m)
#pragma unroll
                    for (int n = 0; n < 2; ++n) acc[a][b][m][n] = (f32x4){0.f, 0.f, 0.f, 0.f};
        cur = nxt; cA = nA; cB = nB; ++ui;
        if constexpr (ALIGN_EPI) { if (wr == 1) PG8_BAR; }
    }
    PG8_WAIT_V(0);
    if constexpr (!ALIGN_EPI) { if (wr == 0) PG8_BAR; }
    PG8_BAR;
#undef PG8_AT
#undef PG8_SA
#undef PG8_SB
#undef PG8_STAGE
#undef PG8_LDA
#undef PG8_LDB
#undef PG8_MMA
#undef PG8_WAIT_V
#undef PG8_WAIT_L
#undef PG8_BAR
#undef PG8_SCHED
}
}

constexpr int NWAVES = 8, NTHR = 512;
constexpr int BATCH = 4, SEQ = 4096, DM = 1024, NMETA = 16, LSEQ = SEQ + NMETA;
constexpr int RV = BATCH * LSEQ;
constexpr int RP = 16640;
constexpr int MTOK = BATCH * SEQ;
constexpr int NIN = 5888;
constexpr int MH = 4, MDV = 256, MDK = 128, NAH = 8, NADH = 64, NAI = 512, DFF = 4096;
constexpr int NCHUNK = 65;
constexpr float EPS = 1e-6f;

constexpr size_t MiB = 1u << 20, QMiB = 1u << 18;
constexpr size_t WS_CTL = 0, CTL_ZERO_BYTES = 128 * 1024;
constexpr size_t WS_WIN = 3 * MiB;
constexpr size_t WS_WQK = 58 * QMiB;
constexpr size_t WS_WA = 15 * MiB;
constexpr size_t WS_WB = 17 * MiB;
constexpr size_t WS_WOUT = 18 * MiB;
constexpr size_t WS_RA = 20 * MiB;
constexpr size_t WS_VR = WS_RA, WS_WFF1 = WS_RA, WS_WFF2 = WS_RA + 8 * MiB;
constexpr size_t WS_SFRAG = 3 * MiB;
constexpr size_t WS_RB = 145 * QMiB;
constexpr size_t WS_XM = WS_RB, WS_H2B = WS_RB;
constexpr size_t WS_RC = 275 * QMiB;
constexpr size_t WS_SO = WS_RC, WS_MIX = WS_RC;
constexpr size_t WS_QN = 405 * QMiB;
constexpr size_t WS_KN = 470 * QMiB;
constexpr size_t WS_YB = 535 * QMiB;
constexpr size_t WS_FAC = WS_YB;
constexpr size_t WS_YA = 730 * QMiB;
constexpr size_t WS_RG = 150 * MiB;
constexpr size_t WS_XN = WS_RG, WS_XC = WS_RG, WS_HF = WS_RG;
constexpr size_t WS_QKM = 730 * QMiB;
constexpr size_t WS_HB = 215 * MiB;
constexpr size_t WS_GATES = 247 * MiB;
constexpr size_t WS_SCAL = 994 * QMiB;
constexpr size_t WS_ROWSS = 1002 * QMiB;
constexpr size_t WS_HID = WS_QN;
constexpr size_t WS_END = 256 * MiB;
constexpr size_t SCAL_ARR = (size_t)32 * NCHUNK * 64;
static_assert(WS_SFRAG + (size_t)32 * 64 * 6 * 1024 <= WS_WA && WS_GATES + (size_t)RP * 16 * 4 <= WS_SCAL && WS_SCAL + 3 * SCAL_ARR * 4 <= WS_ROWSS && WS_ROWSS + (size_t)MTOK * 16 * 4 <= WS_END, "small buffers");
static_assert(WS_YB + (size_t)MTOK * 512 * 2 <= WS_RG && WS_HID + (size_t)MTOK * DFF * 2 <= WS_GATES && WS_H2B + (size_t)MTOK * DM * 2 <= WS_RC, "ws map");
constexpr int CW_BAR = 4096;

constexpr int RING_BYTES = 131072;
constexpr int LDSCTL_OFF = 146944, MISC_OFF = LDSCTL_OFF + 320;
constexpr int LDS_BYTES = 147456;

#define GAS __attribute__((address_space(1)))
#define LAS __attribute__((address_space(3)))
typedef unsigned short bf16;
typedef unsigned v4u __attribute__((ext_vector_type(4)));
typedef unsigned v2u __attribute__((ext_vector_type(2)));
typedef float f32x4 __attribute__((ext_vector_type(4)));
typedef short bf16x8 __attribute__((ext_vector_type(8)));
typedef short s16x4 __attribute__((ext_vector_type(4)));
typedef GAS unsigned gu32;
#define RLX_AGENT __ATOMIC_RELAXED, __HIP_MEMORY_SCOPE_AGENT
#define LDS_WAIT() asm volatile("s_waitcnt lgkmcnt(0)" ::: "memory")
__device__ __forceinline__ unsigned f2bf(float f) { unsigned u = __builtin_bit_cast(unsigned, f); return (u + 0x7fffu + ((u >> 16) & 1u)) >> 16; }
__device__ __forceinline__ unsigned pk2(float lo, float hi) { return f2bf(lo) | (f2bf(hi) << 16); }
__device__ __forceinline__ float bflo(unsigned u) { return __builtin_bit_cast(float, u << 16); }
__device__ __forceinline__ float bfhi(unsigned u) { return __builtin_bit_cast(float, u & 0xffff0000u); }
__device__ __forceinline__ float bf1(unsigned short u) { return __builtin_bit_cast(float, (unsigned)u << 16); }
__device__ __forceinline__ float sigmoidf_(float x) { return __builtin_amdgcn_rcpf(1.0f + __expf(-x)); }

#define XB_TMO      128
#define XB_XCNT(j)  (256  + 64 * (j))
#define XB_XSUB(j)  (1280 + 64 * (j))
#define XB_XGEN(j)  (2304 + 64 * (j))
#define XB_TOP      3328
#define XB_TOPGEN   3392
#define XCD_BAR_WORDS 3456
#define XB_SPIN_CAP (1u << 22)

__device__ __forceinline__ unsigned xb_ld(unsigned* p)              { return __hip_atomic_load(p, __ATOMIC_RELAXED, __HIP_MEMORY_SCOPE_AGENT); }
__device__ __forceinline__ unsigned xb_add(unsigned* p, unsigned v) { return __hip_atomic_fetch_add(p, v, __ATOMIC_RELAXED, __HIP_MEMORY_SCOPE_AGENT); }
__device__ __forceinline__ unsigned xb_xcc_id() { return (unsigned)__builtin_amdgcn_s_getreg((3 << 11) | 20) & 0xFu; }
#define XB_SPIN(cond, bar) do { unsigned _sp = 0; while (cond) { __builtin_amdgcn_s_sleep(1); \
    if ((++_sp & 255u) == 0u) { if (xb_ld(&(bar)[XB_TMO])) break; if (_sp > XB_SPIN_CAP) { atomicAdd(&(bar)[XB_TMO], 1u); break; } } } } while (0)

struct XcdBarrier { unsigned* bar; unsigned x; volatile LAS unsigned* st; };

__device__ __forceinline__ XcdBarrier xcd_barrier_post(unsigned* bar, volatile LAS unsigned* st) {
    XcdBarrier b; b.bar = bar; b.x = xb_xcc_id(); b.st = st;
    if (threadIdx.x == 0) (void)xb_add(&bar[XB_XCNT(b.x)], 1u);
    return b;
}
__device__ __forceinline__ void xcd_barrier_complete(unsigned* bar, unsigned x, unsigned& nloc, unsigned& nx) {
    const unsigned G = gridDim.x * gridDim.y * gridDim.z;
    unsigned sum, cnt, mine, sp = 0u;
    for (;;) {
        sum = 0u; cnt = 0u; mine = 0u;
#pragma unroll
        for (unsigned j = 0; j < 16; ++j) { const unsigned c = xb_ld(&bar[XB_XCNT(j)]); sum += c; cnt += (c > 0u) ? 1u : 0u; mine = (j == x) ? c : mine; }
        if (sum == G) break;
        __builtin_amdgcn_s_sleep(1);
        if ((++sp & 255u) == 0u) { if (xb_ld(&bar[XB_TMO])) break; if (sp > XB_SPIN_CAP) { atomicAdd(&bar[XB_TMO], 1u); break; } }
    }
    nloc = mine > 0u ? mine : 1u; nx = cnt > 0u ? cnt : 1u;
}
__device__ __forceinline__ void xcd_barrier(const XcdBarrier& b) {
    asm volatile("s_waitcnt vmcnt(0)" ::: "memory");
    __syncthreads();
    if (threadIdx.x == 0) {
        unsigned* bar = b.bar;
        __builtin_amdgcn_s_waitcnt(0);
        unsigned nloc = b.st[0], nx = b.st[1];
        if (nloc == 0u) { xcd_barrier_complete(bar, b.x, nloc, nx); b.st[0] = nloc; b.st[1] = nx; }
        const unsigned old = xb_add(&bar[XB_XSUB(b.x)], 1u);
        const unsigned gen = old / nloc;
        if (old + 1u == (gen + 1u) * nloc) {
            __builtin_amdgcn_fence(__ATOMIC_RELEASE, "agent");
            asm volatile("s_waitcnt vmcnt(0)" ::: "memory");
            const unsigned og = xb_add(&bar[XB_TOP], 1u);
            const unsigned tg = og / nx;
            if (og + 1u == (tg + 1u) * nx) xb_add(&bar[XB_TOPGEN], 1u);
            else XB_SPIN(xb_ld(&bar[XB_TOPGEN]) == tg, bar);
            __builtin_amdgcn_fence(__ATOMIC_ACQUIRE, "agent");
            xb_add(&bar[XB_XGEN(b.x)], 1u);
            asm volatile("s_waitcnt vmcnt(0)" ::: "memory");
        } else {
            XB_SPIN(xb_ld(&bar[XB_XGEN(b.x)]) == gen, bar);
            __builtin_amdgcn_fence(__ATOMIC_ACQUIRE, "agent");
            asm volatile("s_waitcnt vmcnt(0)" ::: "memory");
        }
    }
    __syncthreads();
}

__device__ __forceinline__ void sb_arrive(const XcdBarrier& b, unsigned* w) {
    asm volatile("s_waitcnt vmcnt(0)" ::: "memory");
    __syncthreads();
    if (threadIdx.x == 0) {
        __builtin_amdgcn_s_waitcnt(0);
        unsigned nloc = b.st[0], nx = b.st[1];
        if (nloc == 0u) { xcd_barrier_complete(b.bar, b.x, nloc, nx); b.st[0] = nloc; b.st[1] = nx; }
        const unsigned old = xb_add(&w[64 * b.x], 1u);
        if (old + 1u == nloc) {
            __builtin_amdgcn_fence(__ATOMIC_RELEASE, "agent");
            asm volatile("s_waitcnt vmcnt(0)" ::: "memory");
            xb_add(&w[1024], 1u);
        }
    }
}
__device__ __forceinline__ void sb_wait_lane0(const XcdBarrier& b, unsigned* w) {
    const unsigned nx = b.st[1];
    XB_SPIN(xb_ld(&w[1024]) < nx, b.bar);
    __builtin_amdgcn_fence(__ATOMIC_ACQUIRE, "agent");
    asm volatile("s_waitcnt vmcnt(0)" ::: "memory");
}

__device__ __forceinline__ float wave_sum(float v) {
#pragma unroll
    for (int o = 1; o < 64; o <<= 1) v += __shfl_xor(v, o);
    return v;
}

struct Ptrs {
    const float *x, *meta, *norm1_g, *w_in, *conv_w, *conv_b, *wq, *wk, *gate_b, *mnorm_g, *mskip, *qn_g, *kn_g, *rpb, *mbias, *w_a, *w_b, *w_out, *norm2_g, *w_ff1, *w_ff2;
    float* out; unsigned char* ws;
};
#define WSP(T, off) ((T*)(p.ws + (off)))

constexpr int SCR_STRIDE = 18368;
__device__ __forceinline__ void p0_tr64(const float* W, int ldw, int srccol0, int nvalid, bf16* WT, int pitch, int drow0, int k0, int kdst0, const float* kscale, float scale, LAS float* scr, int lane, int hi_skip = 0) {
    (void)scr;
    const int n4 = lane & 15, kq = lane >> 4; if (n4 >= 8) srccol0 += hi_skip;
    f32x4 v[2][8];
#pragma unroll
    for (int hk = 0; hk < 2; ++hk)
#pragma unroll
        for (int j = 0; j < 8; ++j) { v[hk][j] = (f32x4){0.f, 0.f, 0.f, 0.f}; if (4 * n4 < nvalid) v[hk][j] = *(const GAS f32x4*)(W + (size_t)(k0 + 32 * hk + 8 * kq + j) * ldw + srccol0 + 4 * n4); }
#pragma unroll
    for (int hk = 0; hk < 2; ++hk) { float s[8];
#pragma unroll
        for (int j = 0; j < 8; ++j) { s[j] = scale; if (kscale) s[j] *= kscale[k0 + 32 * hk + 8 * kq + j]; }
#pragma unroll
        for (int e = 0; e < 4; ++e) { v4u o; o.x = pk2(v[hk][0][e] * s[0], v[hk][1][e] * s[1]); o.y = pk2(v[hk][2][e] * s[2], v[hk][3][e] * s[3]); o.z = pk2(v[hk][4][e] * s[4], v[hk][5][e] * s[5]); o.w = pk2(v[hk][6][e] * s[6], v[hk][7][e] * s[7]);
            *(GAS v4u*)(WT + (size_t)(drow0 + 4 * n4 + e) * pitch + kdst0 + k0 + 32 * hk + 8 * kq) = o; } }
}
__device__ __forceinline__ void p0_plain(const float* W, int K, int N, bf16* WT, int pitch, int kdst0, const float* kscale, float scale, LAS float* scr, int item, int lane) {
    const int nblk = N / 64, kb = item / nblk, nb = item % nblk;
    p0_tr64(W, N, 64 * nb, 64, WT, pitch, 64 * nb, 64 * kb, kdst0, kscale, scale, scr, lane);
}
template <int PART>
__device__ __forceinline__ void p0_prologue(const Ptrs& p, LAS unsigned char* lds, int gw, int NGW, int wave, int lane) {
    LAS float* scr = (LAS float*)(lds + wave * SCR_STRIDE);
    constexpr int I_IN = 16 * (NIN / 64), I_QK = 4 * 2 * 4 * 2, I_A = 16 * 16, I_B = 8 * 16, I_O = 16 * 16;
    constexpr int NITEMS = I_IN + I_QK + I_A + I_B + I_O;
    for (int it = (PART == 0 ? gw : I_IN + I_QK + gw); it < (PART == 0 ? I_IN + I_QK : NITEMS); it += NGW) {
        int r = it;
        if (r < I_IN) { const int nblk = NIN / 64, kb = r / nblk, nb = r % nblk, n0 = 64 * nb;
            int src, nv;
            int hs = 0;
            if (n0 < 2048) { src = n0; nv = 64; }
            else if (n0 < 3072) { const int t = (n0 - 2048) >> 8, w = (n0 - 2048) & 255, bj = w >> 7, hl = (w & 127) >> 5;
                src = (t < 2 ? 2064 : 2576) + (4 * (t & 1) + hl) * 64 + 32 * bj; nv = 64; hs = 32; }
            else if (n0 < 3584) { src = n0 + 16; nv = 64; }
            else if (n0 < 5632) { const int k = (n0 - 3584) >> 8, w = (n0 - 3584) & 255; src = (w < 128 ? 3600 : 4624 - 128) + 128 * k + w; nv = 64; }
            else if (n0 == 5632) { src = 2048; nv = 16; } else { src = 0; nv = 0; }
            p0_tr64(p.w_in, 5648, src, nv, WSP(bf16, WS_WIN), 1024, n0, 64 * kb, 0, nullptr, 1.f, scr, lane, hs); continue; } r -= I_IN;
        if (r < I_QK) { const int h = r >> 4, qk = (r >> 3) & 1, sub = r & 7, kb = sub >> 1, nb = sub & 1;
            const float* W = (qk ? p.wk : p.wq) + (size_t)h * 256 * 128;
            p0_tr64(W, 128, 64 * nb, 64, WSP(bf16, WS_WQK) + (size_t)h * 256 * 256, 256, qk * 128 + 64 * nb, 64 * kb, 0, nullptr, qk ? 0.08838834764831845f : 1.f, scr, lane); continue; } r -= I_QK;
        if (r < I_A) { p0_plain(p.w_a, 1024, 1024, WSP(bf16, WS_WA), 1536, 0, nullptr, 1.f, scr, r, lane); continue; } r -= I_A;
        if (r < I_B) { p0_plain(p.w_b, 512, 1024, WSP(bf16, WS_WA), 1536, 1024, nullptr, 1.f, scr, r, lane); continue; } r -= I_B;
        p0_plain(p.w_out, 1024, 1024, WSP(bf16, WS_WOUT), 1024, 0, nullptr, 1.f, scr, r, lane);
    }
    if constexpr (PART == 1) return;
    bf16* XN = WSP(bf16, WS_XN);
    const GAS f32x4* g1 = (const GAS f32x4*)p.norm1_g + lane;
    for (int row0 = 2 * (NGW - 1 - gw); row0 < RP; row0 += 2 * NGW) {
        f32x4 v[2][4]; float s[2] = {0.f, 0.f};
#pragma unroll
        for (int q = 0; q < 2; ++q) { const int row = row0 + q;
            if (row < RV) { const int b = row / LSEQ, l = row - b * LSEQ;
                const float* src = (l < NMETA) ? p.meta + (size_t)l * DM : p.x + ((size_t)b * SEQ + (l - NMETA)) * DM;
                const GAS f32x4* xr = (const GAS f32x4*)src + lane;
#pragma unroll
                for (int j = 0; j < 4; ++j) v[q][j] = xr[64 * j]; }
            else {
#pragma unroll
                for (int j = 0; j < 4; ++j) v[q][j] = (f32x4){0.f, 0.f, 0.f, 0.f}; } }
#pragma unroll
        for (int q = 0; q < 2; ++q)
#pragma unroll
            for (int j = 0; j < 4; ++j) s[q] += (v[q][j].x * v[q][j].x + v[q][j].y * v[q][j].y) + (v[q][j].z * v[q][j].z + v[q][j].w * v[q][j].w);
#pragma unroll
        for (int q = 0; q < 2; ++q) { const float rs = 1.0f / sqrtf(wave_sum(s[q]) * (1.f / DM) + EPS);
            GAS unsigned long long* o8 = (GAS unsigned long long*)(XN + (size_t)(row0 + q) * DM) + lane;
#pragma unroll
            for (int j = 0; j < 4; ++j) { const f32x4 g = g1[64 * j]; o8[64 * j] = (unsigned long long)pk2(v[q][j].x * rs * g.x, v[q][j].y * rs * g.y) | ((unsigned long long)pk2(v[q][j].z * rs * g.z, v[q][j].w * rs * g.w) << 32); } }
    }
}
template <int PART>
__device__ __forceinline__ void p_ffw(const Ptrs& p, LAS unsigned char* lds, int gw, int NGW, int wave, int lane) {
    constexpr int I_1 = 16 * 64, I_2 = 64 * 16;
    for (int it = gw; it < (PART == 0 ? I_1 : I_2); it += NGW) {
        if constexpr (PART == 0) p0_plain(p.w_ff1, 1024, 4096, WSP(bf16, WS_WFF1), 1024, 0, p.norm2_g, 1.f, nullptr, it, lane);
        else p0_plain(p.w_ff2, 4096, 1024, WSP(bf16, WS_WFF2), 4096, 0, nullptr, 1.f, nullptr, it, lane);
    }
}

struct EpiIn {
    static constexpr bool PERM = true; static constexpr int MID_T = -1;
    unsigned char* ws; float* out; const float* qng; const float* kng;
    __device__ __forceinline__ void operator()(const pg8::f32x4 (&acc)[2][2][4][2], const pg8::Unit& u, int wr, int wc, int fr, int fq) const {
        using namespace pg8;
        const int row0 = u.pm * BM + wr * 64 + fr, pn = u.pn;
        const int cl = wc * 32 + 8 * fq;
        if (pn == 22) {
            if (wc == 0 && fq < 2) { float* G = (float*)(ws + WS_GATES);
#pragma unroll
                for (int ai = 0; ai < 2; ++ai)
#pragma unroll
                    for (int m = 0; m < 4; ++m) { float* rp = G + (size_t)(row0 + ai * HALF + m * 16) * 16 + 8 * fq;
                        *(f32x4*)rp = acc[ai][0][m][0]; *(f32x4*)(rp + 4) = acc[ai][0][m][1]; } }
            return; }
        if (pn >= 8 && pn < 12) {
            const bool isk = pn >= 10; const int head = 4 * (pn & 1) + wc; bf16_t* base = (bf16_t*)(ws + (isk ? WS_KN : WS_QN)) + head * 64 + 8 * fq;
            const float* gp = (isk ? kng : qng) + 8 * fq; float gn[2][8];
#pragma unroll
            for (int bj = 0; bj < 2; ++bj)
#pragma unroll
                for (int e = 0; e < 8; ++e) gn[bj][e] = gp[32 * bj + e] * (isk ? 1.0f : 0.125f * 1.4426950408889634f);
#pragma unroll
            for (int ai = 0; ai < 2; ++ai)
#pragma unroll
                for (int m = 0; m < 4; ++m) { const int row = row0 + ai * HALF + m * 16; float ss = 0.f;
#pragma unroll
                    for (int bj = 0; bj < 2; ++bj)
#pragma unroll
                        for (int n = 0; n < 2; ++n) { const f32x4 v = acc[ai][bj][m][n]; ss += (v[0] * v[0] + v[1] * v[1]) + (v[2] * v[2] + v[3] * v[3]); }
                    ss += __shfl_xor(ss, 16); ss += __shfl_xor(ss, 32);
                    const float rs = 1.0f / sqrtf(ss * (1.f / 64.f) + EPS);
#pragma unroll
                    for (int bj = 0; bj < 2; ++bj) { const f32x4 v0 = acc[ai][bj][m][0] * rs, v1 = acc[ai][bj][m][1] * rs;
                        u32x4 w; w.x = cvt_pk_bf16(v0[0] * gn[bj][0], v0[1] * gn[bj][1]); w.y = cvt_pk_bf16(v0[2] * gn[bj][2], v0[3] * gn[bj][3]); w.z = cvt_pk_bf16(v1[0] * gn[bj][4], v1[1] * gn[bj][5]); w.w = cvt_pk_bf16(v1[2] * gn[bj][6], v1[3] * gn[bj][7]);
                        *(u32x4*)(base + (size_t)row * 512 + 32 * bj) = w; } }
            return; }
        bf16_t* base; int ldc, col; bool sig = false, tok = false;
        if (pn < 4) { base = (bf16_t*)(ws + WS_XM); ldc = 1024; col = pn * 256; }
        else if (pn < 8) { base = (bf16_t*)(ws + WS_SO); ldc = 1024; col = (pn - 4) * 256; sig = true; }
        else if (pn < 14) { base = (bf16_t*)(ws + WS_VR); ldc = 512; col = (pn - 12) * 256; }
        else {
            bf16_t* GR = (bf16_t*)out; bf16_t* GB = (bf16_t*)out + (size_t)MTOK * 1024; const int gcol = (pn - 14) * 128 + cl;
#pragma unroll
            for (int ai = 0; ai < 2; ++ai)
#pragma unroll
                for (int m = 0; m < 4; ++m) {
                    int row = row0 + ai * HALF + m * 16; const int b = row / LSEQ, l = row - b * LSEQ; if (row >= RV || l < NMETA) continue; row = b * SEQ + l - NMETA;
                    float gr[8], gb[8];
#pragma unroll
                    for (int n = 0; n < 2; ++n)
#pragma unroll
                        for (int e = 0; e < 4; ++e) { const float ea = __expf(-acc[ai][0][m][n][e]), eb2 = __expf(-acc[ai][1][m][n][e]); const float sb = __builtin_amdgcn_rcpf(1.0f + eb2);
                            gb[4 * n + e] = sb; gr[4 * n + e] = (1.0f + eb2) * __builtin_amdgcn_rcpf(1.0f + ea); }
                    u32x4 w; w.x = cvt_pk_bf16(gr[0], gr[1]); w.y = cvt_pk_bf16(gr[2], gr[3]); w.z = cvt_pk_bf16(gr[4], gr[5]); w.w = cvt_pk_bf16(gr[6], gr[7]);
                    *(u32x4*)(GR + (size_t)row * 1024 + gcol) = w;
                    w.x = cvt_pk_bf16(gb[0], gb[1]); w.y = cvt_pk_bf16(gb[2], gb[3]); w.z = cvt_pk_bf16(gb[4], gb[5]); w.w = cvt_pk_bf16(gb[6], gb[7]);
                    *(u32x4*)(GB + (size_t)row * 1024 + gcol) = w; }
            return; }
#pragma unroll
        for (int ai = 0; ai < 2; ++ai)
#pragma unroll
            for (int m = 0; m < 4; ++m) {
                int row = row0 + ai * HALF + m * 16; bool ok = true;
                if (tok) { const int b = row / LSEQ, l = row - b * LSEQ; ok = (row < RV) && (l >= NMETA); row = b * SEQ + l - NMETA; }
                if (!ok) continue;
                bf16_t* rowp = base + (size_t)row * ldc + col + cl;
#pragma unroll
                for (int bj = 0; bj < 2; ++bj) { f32x4 v0 = acc[ai][bj][m][0], v1 = acc[ai][bj][m][1];
                    if (sig) {
#pragma unroll
                        for (int e = 0; e < 4; ++e) { v0[e] = sigmoidf_(v0[e]); v1[e] = sigmoidf_(v1[e]); } }
                    u32x4 w; w.x = cvt_pk_bf16(v0[0], v0[1]); w.y = cvt_pk_bf16(v0[2], v0[3]); w.z = cvt_pk_bf16(v1[0], v1[1]); w.w = cvt_pk_bf16(v1[2], v1[3]);
                    *(u32x4*)(rowp + bj * HALF) = w; } }
    }
};

__device__ __forceinline__ void conv_silu16(const bf16* XM, int b, int l, int lane, const float (&cw)[3][16], const float (&cb)[16], float (&o)[16]) {
    const bf16* r1 = XM + ((size_t)b * LSEQ + l) * DM + 16 * lane;
    v4u a0[2] = {{0, 0, 0, 0}, {0, 0, 0, 0}}, a1[2], a2[2] = {{0, 0, 0, 0}, {0, 0, 0, 0}};
    a1[0] = *(const GAS v4u*)r1; a1[1] = *(const GAS v4u*)(r1 + 8);
    if (l > 0) { a0[0] = *(const GAS v4u*)(r1 - DM); a0[1] = *(const GAS v4u*)(r1 - DM + 8); }
    if (l < LSEQ - 1) { a2[0] = *(const GAS v4u*)(r1 + DM); a2[1] = *(const GAS v4u*)(r1 + DM + 8); }
#pragma unroll
    for (int q = 0; q < 2; ++q)
#pragma unroll
        for (int e = 0; e < 4; ++e) {
            const int c = q * 8 + e * 2;
            const float y0 = cb[c] + cw[0][c] * bflo(a0[q][e]) + cw[1][c] * bflo(a1[q][e]) + cw[2][c] * bflo(a2[q][e]);
            const float y1 = cb[c + 1] + cw[0][c + 1] * bfhi(a0[q][e]) + cw[1][c + 1] * bfhi(a1[q][e]) + cw[2][c + 1] * bfhi(a2[q][e]);
            o[c] = y0 * sigmoidf_(y0); o[c + 1] = y1 * sigmoidf_(y1); }
}
__device__ __forceinline__ void load_conv_w(const Ptrs& p, int lane, float (&cw)[3][16], float (&cb)[16]) {
#pragma unroll
    for (int j = 0; j < 3; ++j)
#pragma unroll
        for (int q = 0; q < 4; ++q) { const f32x4 v = *(const GAS f32x4*)(p.conv_w + (size_t)j * DM + 16 * lane + 4 * q); cw[j][4 * q] = v.x; cw[j][4 * q + 1] = v.y; cw[j][4 * q + 2] = v.z; cw[j][4 * q + 3] = v.w; }
#pragma unroll
    for (int q = 0; q < 4; ++q) { const f32x4 v = *(const GAS f32x4*)(p.conv_b + 16 * lane + 4 * q); cb[4 * q] = v.x; cb[4 * q + 1] = v.y; cb[4 * q + 2] = v.z; cb[4 * q + 3] = v.w; }
}
__device__ __forceinline__ v4u conv_silu8_raw(const v4u a0, const v4u a1, const v4u a2, const float (&cw)[3][8], const float (&cb)[8]) {
    v4u o;
#pragma unroll
    for (int e = 0; e < 4; ++e) { const int c = 2 * e;
        const float y0 = cb[c] + cw[0][c] * bflo(a0[e]) + cw[1][c] * bflo(a1[e]) + cw[2][c] * bflo(a2[e]);
        const float y1 = cb[c + 1] + cw[0][c + 1] * bfhi(a0[e]) + cw[1][c + 1] * bfhi(a1[e]) + cw[2][c + 1] * bfhi(a2[e]);
        o[e] = pk2(y0 * sigmoidf_(y0), y1 * sigmoidf_(y1)); }
    return o;
}
__device__ __forceinline__ v4u conv_silu8(const bf16* XM, int b, int l, int col0, const float (&cw)[3][8], const float (&cb)[8]) {
    const bf16* r1 = XM + ((size_t)b * LSEQ + l) * DM + col0;
    v4u a0 = {0, 0, 0, 0}, a2 = {0, 0, 0, 0}; const v4u a1 = *(const GAS v4u*)r1;
    if (l > 0) a0 = *(const GAS v4u*)(r1 - DM);
    if (l < LSEQ - 1) a2 = *(const GAS v4u*)(r1 + DM);
    return conv_silu8_raw(a0, a1, a2, cw, cb);
}
__device__ __forceinline__ void load_conv_w8(const Ptrs& p, int col0, float (&cw)[3][8], float (&cb)[8]) {
#pragma unroll
    for (int j = 0; j < 3; ++j)
#pragma unroll
        for (int q = 0; q < 2; ++q) { const f32x4 v = *(const GAS f32x4*)(p.conv_w + (size_t)j * DM + col0 + 4 * q); cw[j][4 * q] = v.x; cw[j][4 * q + 1] = v.y; cw[j][4 * q + 2] = v.z; cw[j][4 * q + 3] = v.w; }
#pragma unroll
    for (int q = 0; q < 2; ++q) { const f32x4 v = *(const GAS f32x4*)(p.conv_b + col0 + 4 * q); cb[4 * q] = v.x; cb[4 * q + 1] = v.y; cb[4 * q + 2] = v.z; cb[4 * q + 3] = v.w; }
}
__device__ __forceinline__ void gate_scalars(const Ptrs& p, int gw, int NGW, int lane) {
    const float* GT = WSP(float, WS_GATES); float* SB = WSP(float, WS_SCAL); float* SG = SB + SCAL_ARR; float* SPM = SG + SCAL_ARR;
    for (int it = gw; it < 32 * NCHUNK; it += NGW) {
        const int seq = it / NCHUNK, c = it - seq * NCHUNK, dir = seq & 1, h = (seq >> 1) & 3, b = seq >> 3;
        const int l = dir ? (LSEQ - 1 - 64 * c - lane) : (64 * c + lane - 48);
        float li = -1e9f, lf = 0.f;
        if (l >= 0) { const float* gr = GT + ((size_t)b * LSEQ + l) * 16 + dir * 8 + h;
            li = gr[0] + p.gate_b[(dir * 2) * 4 + h];
            const float f = gr[4] + p.gate_b[(dir * 2 + 1) * 4 + h];
            lf = -(fmaxf(-f, 0.f) + log1pf(expf(-fabsf(f)))); }
        float bs = lf;
#pragma unroll
        for (int o = 1; o < 64; o <<= 1) { const float t = __shfl_up(bs, o); if (lane >= o) bs += t; }
        const float gg = li - bs; float pm = gg;
#pragma unroll
        for (int o = 1; o < 64; o <<= 1) { const float t = __shfl_up(pm, o); if (lane >= o) pm = fmaxf(pm, t); }
        const size_t idx = (size_t)it * 64 + lane; SB[idx] = bs; SG[idx] = gg; SPM[idx] = pm;
    }
}
__device__ __forceinline__ void p3_head(const Ptrs& p, LAS unsigned char* lds, int pm, int h, int vcu, int gw, int NGW, int wave, int lane) {
    const bf16* XM = WSP(bf16, WS_XM); bf16* XC = WSP(bf16, WS_XC);
    const int col0 = h * 256 + 8 * (lane & 31);
    const bool extra = vcu < 16;
    const int rt = vcu & 3, hh = (vcu >> 2) & 3, c16 = lane & 15, g = lane >> 4;
    bf16x8 bfr[2][8];
    { float cw[3][8], cb[8]; load_conv_w8(p, col0, cw, cb);
      const int rbase = 256 * pm + 32 * wave + 16 * (lane >> 5);
      v4u rw[18];
#pragma unroll
      for (int i = 0; i < 18; ++i) { const int row = rbase + i - 1, b = (row < 0 ? 0 : row) / LSEQ, l = row - b * LSEQ; rw[i] = (v4u){0, 0, 0, 0};
          if (row >= 0 && row < RV) rw[i] = *(const GAS v4u*)(XM + (size_t)row * DM + col0); (void)l; }
      v4u xa0 = {0, 0, 0, 0}, xa1 = {0, 0, 0, 0}, xa2 = {0, 0, 0, 0};
      const int xrow = MTOK + 16 * rt + 2 * wave + (lane >> 5), xb = xrow / LSEQ, xl = xrow - xb * LSEQ, colx = hh * 256 + 8 * (lane & 31);
      if (extra) { const bf16* r1 = XM + (size_t)xrow * DM + colx; xa1 = *(const GAS v4u*)r1; if (xl > 0) xa0 = *(const GAS v4u*)(r1 - DM); if (xl < LSEQ - 1) xa2 = *(const GAS v4u*)(r1 + DM);
#pragma unroll
          for (int t2 = 0; t2 < 2; ++t2) { const bf16* bp = WSP(bf16, WS_WQK) + (size_t)(hh * 256 + 16 * (2 * wave + t2) + c16) * 256 + 8 * g;
#pragma unroll
              for (int ks = 0; ks < 8; ++ks) bfr[t2][ks] = *(const GAS bf16x8*)(bp + 32 * ks); } }
#pragma unroll
      for (int i = 0; i < 16; ++i) { const int row = rbase + i, b = row / LSEQ, l = row - b * LSEQ;
          const v4u a0 = (l > 0) ? rw[i] : (v4u){0, 0, 0, 0}, a1 = rw[i + 1], a2 = (l < LSEQ - 1) ? rw[i + 2] : (v4u){0, 0, 0, 0};
          v4u o;
#pragma unroll
          for (int e = 0; e < 4; ++e) { const int cc = 2 * e;
              const float y0 = cb[cc] + cw[0][cc] * bflo(a0[e]) + cw[1][cc] * bflo(a1[e]) + cw[2][cc] * bflo(a2[e]);
              const float y1 = cb[cc + 1] + cw[0][cc + 1] * bfhi(a0[e]) + cw[1][cc + 1] * bfhi(a1[e]) + cw[2][cc + 1] * bfhi(a2[e]);
              o[e] = pk2(y0 * sigmoidf_(y0), y1 * sigmoidf_(y1)); }
          *(GAS v4u*)(XC + (size_t)row * DM + col0) = o; }
      if (extra) { float cwx[3][8], cbx[8]; load_conv_w8(p, colx, cwx, cbx);
          *(LAS v4u*)(lds + (2 * wave + (lane >> 5)) * 528 + 16 * (lane & 31)) = conv_silu8_raw(xa0, xa1, xa2, cwx, cbx); } }
    gate_scalars(p, gw, NGW, lane);
    if (extra) {
        __syncthreads();
        bf16x8 af[8];
#pragma unroll
        for (int ks = 0; ks < 8; ++ks) af[ks] = *(const LAS bf16x8*)(lds + c16 * 528 + (32 * ks + 8 * g) * 2);
#pragma unroll
        for (int t2 = 0; t2 < 2; ++t2) { const int nt = 2 * wave + t2;
            f32x4 acc = (f32x4){0.f, 0.f, 0.f, 0.f};
#pragma unroll
            for (int ks = 0; ks < 8; ++ks) acc = __builtin_amdgcn_mfma_f32_16x16x32_bf16(bfr[t2][ks], af[ks], acc, 0, 0, 0);
            v2u o; o.x = pg8::cvt_pk_safe(acc[0], acc[1]); o.y = pg8::cvt_pk_safe(acc[2], acc[3]);
            *(GAS v2u*)(WSP(bf16, WS_QKM) + (size_t)(MTOK + 16 * rt + c16) * 1024 + hh * 256 + 16 * nt + 4 * g) = o; }
    }
    asm volatile("s_waitcnt vmcnt(0)" ::: "memory"); __syncthreads();
}

struct EpiStoreBf16 {
    static constexpr bool PERM = true; static constexpr int MID_T = -1;
    bf16* O; int ldc;
    __device__ __forceinline__ void operator()(const pg8::f32x4 (&acc)[2][2][4][2], const pg8::Unit& u, int wr, int wc, int fr, int fq) const {
        using namespace pg8;
        const int row0 = u.pm * BM + wr * 64 + fr, col0 = u.pn * BM + wc * 32 + 8 * fq;
#pragma unroll
        for (int ai = 0; ai < 2; ++ai)
#pragma unroll
            for (int m = 0; m < 4; ++m) { bf16* rowp = O + (size_t)(row0 + ai * HALF + m * 16) * ldc + col0;
#pragma unroll
                for (int bj = 0; bj < 2; ++bj) { const f32x4 v0 = acc[ai][bj][m][0], v1 = acc[ai][bj][m][1];
                    u32x4 w; w.x = cvt_pk_bf16(v0[0], v0[1]); w.y = cvt_pk_bf16(v0[2], v0[3]); w.z = cvt_pk_bf16(v1[0], v1[1]); w.w = cvt_pk_bf16(v1[2], v1[3]);
                    *(u32x4*)(rowp + bj * HALF) = w; } }
    }
};
struct EpiMix {
    static constexpr bool PERM = true; static constexpr int MID_T = 16;
    bf16* MIX; const bf16* GA; const bf16* GB;
    __device__ __forceinline__ void mid(pg8::f32x4 (&acc)[2][2][4][2], const pg8::Unit& u, int wr, int wc, int fr, int fq) const {
        using namespace pg8;
        int row0 = u.pm * BM + wr * 64 + fr; const int col0 = u.pn * BM + wc * 32 + 8 * fq;
        asm volatile("" : "+v"(row0));
#pragma unroll
        for (int ai = 0; ai < 2; ++ai)
#pragma unroll
            for (int m = 0; m < 4; ++m) { const size_t off = (size_t)(row0 + ai * HALF + m * 16) * 1024 + col0;
#pragma unroll
                for (int bj = 0; bj < 2; ++bj) { const u32x4 a = *(const u32x4*)(GA + off + bj * HALF);
                    f32x4& v0 = acc[ai][bj][m][0]; f32x4& v1 = acc[ai][bj][m][1];
                    v0[0] *= bflo(a.x); v0[1] *= bfhi(a.x); v0[2] *= bflo(a.y); v0[3] *= bfhi(a.y); v1[0] *= bflo(a.z); v1[1] *= bfhi(a.z); v1[2] *= bflo(a.w); v1[3] *= bfhi(a.w); }
                asm volatile("" ::: "memory"); }
    }
    __device__ __forceinline__ void operator()(const pg8::f32x4 (&acc)[2][2][4][2], const pg8::Unit& u, int wr, int wc, int fr, int fq) const {
        using namespace pg8;
        const int row0 = u.pm * BM + wr * 64 + fr, col0 = u.pn * BM + wc * 32 + 8 * fq;
#pragma unroll
        for (int ai = 0; ai < 2; ++ai)
#pragma unroll
            for (int m = 0; m < 4; ++m) { const size_t off = (size_t)(row0 + ai * HALF + m * 16) * 1024 + col0;
#pragma unroll
                for (int bj = 0; bj < 2; ++bj) { const f32x4 v0 = acc[ai][bj][m][0], v1 = acc[ai][bj][m][1];
                    const u32x4 gv = *(const u32x4*)(GB + off + bj * HALF);
                    u32x4 w; w.x = cvt_pk_bf16(v0[0] * bflo(gv.x), v0[1] * bfhi(gv.x)); w.y = cvt_pk_bf16(v0[2] * bflo(gv.y), v0[3] * bfhi(gv.y)); w.z = cvt_pk_bf16(v1[0] * bflo(gv.z), v1[1] * bfhi(gv.z)); w.w = cvt_pk_bf16(v1[2] * bflo(gv.w), v1[3] * bfhi(gv.w));
                    *(u32x4*)(MIX + off + bj * HALF) = w; } }
    }
};
struct EpiOut {
    static constexpr bool PERM = false; static constexpr int MID_T = -1;
    const float* X; float* OUT; bf16* H2B; float* ROWSS;
    __device__ __forceinline__ void operator()(const pg8::f32x4 (&acc)[2][2][4][2], const pg8::Unit& u, int wr, int wc, int fr, int fq) const {
        using namespace pg8;
        const int row0 = u.pm * BM + wr * 64 + fr, col0 = u.pn * BM + wc * 32 + 4 * fq;
#pragma unroll
        for (int ai = 0; ai < 2; ++ai)
#pragma unroll
            for (int m = 0; m < 4; ++m) { const int row = row0 + ai * HALF + m * 16; const size_t off = (size_t)row * 1024 + col0; float ss = 0.f;
#pragma unroll
                for (int bj = 0; bj < 2; ++bj)
#pragma unroll
                    for (int n = 0; n < 2; ++n) { const size_t o2 = off + bj * HALF + n * 16; const f32x4 xv = *(const f32x4*)(X + o2); const f32x4 hv = xv + acc[ai][bj][m][n];
                        ss += (hv[0] * hv[0] + hv[1] * hv[1]) + (hv[2] * hv[2] + hv[3] * hv[3]);
                        u32x2 w; w.x = cvt_pk_bf16(hv[0], hv[1]); w.y = cvt_pk_bf16(hv[2], hv[3]); *(u32x2*)(H2B + o2) = w; }
                ss += __shfl_xor(ss, 16); ss += __shfl_xor(ss, 32);
                if (fq == 0) ROWSS[(size_t)row * 16 + u.pn * 4 + wc] = ss; }
    }
};
struct EpiFF1 {
    static constexpr bool PERM = true; static constexpr int MID_T = -1;
    bf16* HID; const float* ROWSS;
    __device__ __forceinline__ void operator()(const pg8::f32x4 (&acc)[2][2][4][2], const pg8::Unit& u, int wr, int wc, int fr, int fq) const {
        using namespace pg8;
        const int row0 = u.pm * BM + wr * 64 + fr, col0 = u.pn * BM + wc * 32 + 8 * fq;
#pragma unroll
        for (int ai = 0; ai < 2; ++ai)
#pragma unroll
            for (int m = 0; m < 4; ++m) { const int row = row0 + ai * HALF + m * 16;
                const f32x4* rp = (const f32x4*)(ROWSS + (size_t)row * 16); const f32x4 a = rp[0], b = rp[1], c = rp[2], d = rp[3];
                const float tot = ((a[0] + a[1]) + (a[2] + a[3])) + ((b[0] + b[1]) + (b[2] + b[3])) + ((c[0] + c[1]) + (c[2] + c[3])) + ((d[0] + d[1]) + (d[2] + d[3]));
                const float rs = 1.0f / sqrtf(tot * (1.f / 1024.f) + EPS);
                bf16* rowp = HID + (size_t)row * DFF + col0;
#pragma unroll
                for (int bj = 0; bj < 2; ++bj) { f32x4 v0 = acc[ai][bj][m][0] * rs, v1 = acc[ai][bj][m][1] * rs;
#pragma unroll
                    for (int e = 0; e < 4; ++e) { const float z0 = fmaxf(v0[e], 0.f), z1 = fmaxf(v1[e], 0.f); v0[e] = z0 * z0; v1[e] = z1 * z1; }
                    u32x4 w; w.x = cvt_pk_bf16(v0[0], v0[1]); w.y = cvt_pk_bf16(v0[2], v0[3]); w.z = cvt_pk_bf16(v1[0], v1[1]); w.w = cvt_pk_bf16(v1[2], v1[3]);
                    *(u32x4*)(rowp + bj * HALF) = w; } }
    }
};
struct EpiFF2 {
    static constexpr bool PERM = false; static constexpr int MID_T = -1;
    float* OUT; const bf16* H2B;
    __device__ __forceinline__ void operator()(const pg8::f32x4 (&acc)[2][2][4][2], const pg8::Unit& u, int wr, int wc, int fr, int fq) const {
        using namespace pg8;
        const int row0 = u.pm * BM + wr * 64 + fr, col0 = u.pn * BM + wc * 32 + 4 * fq;
#pragma unroll
        for (int ai = 0; ai < 2; ++ai)
#pragma unroll
            for (int m = 0; m < 4; ++m) { const size_t off = (size_t)(row0 + ai * HALF + m * 16) * 1024 + col0;
#pragma unroll
                for (int bj = 0; bj < 2; ++bj)
#pragma unroll
                    for (int n = 0; n < 2; ++n) { const size_t o2 = off + bj * HALF + n * 16; const u32x2 hb = *(const u32x2*)(H2B + o2);
                        *(f32x4*)(OUT + o2) = (f32x4){bflo(hb.x), bfhi(hb.x), bflo(hb.y), bfhi(hb.y)} + acc[ai][bj][m][n]; } }
    }
};

__device__ __forceinline__ s16x4 ds_tr16(const LAS unsigned char* a) { return __builtin_bit_cast(s16x4, __builtin_amdgcn_ds_read_tr16_b64_v4i16((LAS s16x4*)a)); }
__device__ __forceinline__ bf16x8 cat8(s16x4 lo, s16x4 hi) { return (bf16x8){lo[0], lo[1], lo[2], lo[3], hi[0], hi[1], hi[2], hi[3]}; }
__device__ __forceinline__ bf16x8 pack8(const float* f) { v4u w; w.x = pg8::cvt_pk_safe(f[0], f[1]); w.y = pg8::cvt_pk_safe(f[2], f[3]); w.z = pg8::cvt_pk_safe(f[4], f[5]); w.w = pg8::cvt_pk_safe(f[6], f[7]); return __builtin_bit_cast(bf16x8, w); }
constexpr int SC_QP = 272, SC_VP = 80;
constexpr int SC_Q = 0, SC_K = 64 * SC_QP, SC_V = 2 * 64 * SC_QP, SC_S = SC_V + 64 * SC_VP, SC_SF = SC_S + 1280, SC_STAGE = SC_SF + 6144;
constexpr int SC_CIMG = 2 * SC_STAGE;
constexpr int SC_NIMG = SC_CIMG + 16384;
constexpr int SC_MC = SC_NIMG + 8192;
constexpr int SC_FL = SC_MC + 544;
static_assert(SC_FL + 4096 <= LDSCTL_OFF && SC_STAGE % 16 == 0, "scan LDS");
#define SF_BASE(tb) ((tb) == 0 ? 0 : (tb) == 1 ? 1 : (tb) == 2 ? 2 : 4)
#define SCHED_FENCE() __builtin_amdgcn_sched_barrier(0)
constexpr int FACW = 320;

__device__ __forceinline__ void scan_setup(const Ptrs& p, LAS unsigned char* lds, int item, int wid, int lane) {
    const int seq = item >> 3;
    const float* SB = WSP(float, WS_SCAL) + (size_t)seq * NCHUNK * 64; const float* SPM = SB + 2 * SCAL_ARR;
    if (wid == 0) {
        const float b63a = SB[(size_t)lane * 64 + 63], p63a = SPM[(size_t)lane * 64 + 63], b63b = SB[(size_t)64 * 64 + 63], p63b = SPM[(size_t)64 * 64 + 63];
        float m = 0.f;
        for (int c = 0; c < 65; ++c) {
            const int cl = c & 63;
            const float bb = (c < 64) ? __builtin_bit_cast(float, __builtin_amdgcn_readlane(__builtin_bit_cast(int, b63a), cl)) : b63b, pp = (c < 64) ? __builtin_bit_cast(float, __builtin_amdgcn_readlane(__builtin_bit_cast(int, p63a), cl)) : p63b;
            const float M63 = fmaxf(m, pp);
            if (lane == 0) { ((LAS float*)(lds + SC_MC))[c] = m; ((LAS float*)(lds + SC_MC))[68 + c] = M63; }
            m = bb + M63; }
    }
    __syncthreads();
}
__device__ __forceinline__ void scan_prepass(const Ptrs& p, LAS unsigned char* lds, int item, int wid, int lane) {
    using pg8::f32x4;
    const int seq = item >> 3, sl = item & 7, dir = seq & 1, h = (seq >> 1) & 3, b = seq >> 3, c16 = lane & 15, g = lane >> 4;
    const int c = 8 * wid + sl, nsteps = dir ? 64 : 65;
    const bool active = c < nsteps && !(dir == 0 && c == 0);
    for (int cc = c; cc < nsteps; cc += 64) {
        if (!(cc < nsteps) || (dir == 0 && cc == 0)) continue;
        const float* SG = WSP(float, WS_SCAL) + SCAL_ARR + (size_t)seq * NCHUNK * 64;
        LAS float* Fl = (LAS float*)(lds + SC_FL + wid * 512);
        { const float* SBq = WSP(float, WS_SCAL) + (size_t)seq * NCHUNK * 64; const float* SPMq = SBq + 2 * SCAL_ARR;
          const float mc = ((const LAS float*)(lds + SC_MC))[cc], M63 = ((const LAS float*)(lds + SC_MC))[68 + cc];
          const float Mt = fmaxf(mc, SPMq[(size_t)cc * 64 + lane]);
          const float Fv = __expf(SG[(size_t)cc * 64 + lane] - M63), Rv = __expf(fminf(M63 - Mt, 80.f));
          Fl[lane] = Fv; Fl[64 + lane] = Rv;
          float* FAC = WSP(float, WS_FAC) + (size_t)(seq * 64 + (dir ? cc : cc - 1)) * FACW;
          FAC[lane] = Fv; FAC[64 + lane] = Rv; FAC[128 + lane] = __expf(mc - Mt); FAC[192 + lane] = __expf(-(SBq[(size_t)cc * 64 + lane] + Mt)); }
        LDS_WAIT(); asm volatile("" ::: "memory");
        const bf16* QKM = WSP(bf16, WS_QKM);
        auto rowp = [&](int t) -> const bf16* { const int l = dir ? (LSEQ - 1 - 64 * cc - t) : (64 * cc + t - 48); return QKM + ((size_t)b * LSEQ + l) * 1024 + h * 256 + 8 * g; };
        v4u* SF = (v4u*)(p.ws + WS_SFRAG) + ((size_t)(seq * 64 + (dir ? cc : cc - 1)) * 6) * 64 + lane;
        bf16x8 qa[4][4], ka[4][4];
#pragma unroll
        for (int tb = 0; tb < 4; ++tb) { const bf16* qp = rowp(16 * tb + c16);
#pragma unroll
            for (int ks = 0; ks < 4; ++ks) { qa[tb][ks] = *(const GAS bf16x8*)(qp + 32 * ks); ka[tb][ks] = *(const GAS bf16x8*)(qp + 128 + 32 * ks); } }
#pragma unroll
        for (int tb = 0; tb < 4; ++tb) {
            f32x4 X[4]; float rsum = 0.f;
#pragma unroll
            for (int sb = 0; sb <= tb; ++sb) {
                f32x4 x = (f32x4){0.f, 0.f, 0.f, 0.f};
#pragma unroll
                for (int ks = 0; ks < 4; ++ks) x = __builtin_amdgcn_mfma_f32_16x16x32_bf16(ka[sb][ks], qa[tb][ks], x, 0, 0, 0);
                const f32x4 F4 = *(const LAS f32x4*)(Fl + 16 * sb + 4 * g);
#pragma unroll
                for (int r = 0; r < 4; ++r) { float v = x[r]; if (sb == tb) v = (4 * g + r <= c16) ? v : 0.f; x[r] = v; rsum += v * F4[r]; }
                X[sb] = x; }
            rsum += __shfl_xor(rsum, 16); rsum += __shfl_xor(rsum, 32);
            if (g == 0) { float* FAC = WSP(float, WS_FAC) + (size_t)(seq * 64 + (dir ? cc : cc - 1)) * FACW; FAC[256 + 16 * tb + c16] = Fl[64 + 16 * tb + c16] * rsum; }
#pragma unroll
            for (int k2 = 0; 2 * k2 <= tb; ++k2) { float sf[8];
#pragma unroll
                for (int j = 0; j < 4; ++j) { sf[j] = X[2 * k2][j]; sf[4 + j] = (2 * k2 + 1 <= tb) ? X[(2 * k2 + 1 <= tb) ? 2 * k2 + 1 : 0][j] : 0.f; }
                SF[(SF_BASE(tb) + k2) * 64] = __builtin_bit_cast(v4u, pack8(sf)); }
        }
        LDS_WAIT(); asm volatile("" ::: "memory");
    }
    (void)active;
}
__device__ __forceinline__ void scan_B(const Ptrs& p, LAS unsigned char* lds, int item, int tid, int wid, int lane) {
    using pg8::f32x4;
    const int seq = item >> 3, sl = item & 7, dir = seq & 1, h = (seq >> 1) & 3, b = seq >> 3;
    const int nsteps = dir ? 64 : 65;
    const int c16 = lane & 15, g = lane >> 4;
    const float* SB = WSP(float, WS_SCAL) + (size_t)seq * NCHUNK * 64; const float* SG = SB + SCAL_ARR; const float* SPM = SG + SCAL_ARR;
    const int qrow0 = (tid >> 4) & 15, qc = tid & 15;
    const int vrow = (tid >> 2) & 63, vpc = tid & 3;
    const int farr = (tid >> 6) & 3, ft = tid & 63;
    const long long rstep = dir ? -64 : 64;
    auto row_l = [&](int c, int t) -> int { return dir ? (LSEQ - 1 - 64 * c - t) : (64 * c + t - 48); };
    const bf16* qkp; const bf16* vp;
    { const bf16* QKM = WSP(bf16, WS_QKM); const bf16* XM = WSP(bf16, WS_XM);
      qkp = QKM + ((size_t)b * LSEQ + row_l(1, qrow0)) * 1024 + h * 256 + 8 * qc;
      vp = XM + ((size_t)b * LSEQ + row_l(1, vrow)) * 1024 + h * 256 + 32 * sl + 8 * vpc; }
    const long long r16 = dir ? -16 * 1024 : 16 * 1024;
    v4u rq[4], rk[4], rv, rs0, rs1 = {0, 0, 0, 0}; float rx1 = 0.f, rx2 = 0.f, rfv = 0.f;
    const float* facb = WSP(float, WS_FAC) + ((size_t)seq * 64 - (dir ? 0 : 1)) * FACW;
    const v4u* sfp = (const v4u*)(p.ws + WS_SFRAG) + ((size_t)seq * 64 - (dir ? 0 : 1)) * 384 + tid;
    auto issue = [&](int c) {
        const long long off = (long long)(c - 1) * rstep * 1024;
#pragma unroll
        for (int i = 0; i < 4; ++i) { rq[i] = *(const GAS v4u*)(qkp + off + i * r16); rk[i] = *(const GAS v4u*)(qkp + off + i * r16 + 128); }
        rv = *(const GAS v4u*)(vp + off);
        rx1 = facb[(size_t)c * FACW + tid]; rfv = facb[(size_t)c * FACW + vrow]; if (tid >= 128 && tid < 192) rx2 = facb[(size_t)c * FACW + 128 + tid];
        rs0 = *(const GAS v4u*)(sfp + (size_t)c * 384); if (tid < 128) rs1 = *(const GAS v4u*)(sfp + (size_t)c * 384 + 256);
    };
    auto commit = [&](int c, int stage) {
        LAS unsigned char* S = lds + stage * SC_STAGE;
#pragma unroll
        for (int i = 0; i < 4; ++i) { const int t = qrow0 + 16 * i; *(LAS v4u*)(S + SC_Q + t * SC_QP + 16 * qc) = rq[i]; *(LAS v4u*)(S + SC_K + t * SC_QP + 16 * qc) = rk[i]; }
        { v4u fv;
          fv.x = pg8::cvt_pk_safe(bflo(rv.x) * rfv, bfhi(rv.x) * rfv); fv.y = pg8::cvt_pk_safe(bflo(rv.y) * rfv, bfhi(rv.y) * rfv); fv.z = pg8::cvt_pk_safe(bflo(rv.z) * rfv, bfhi(rv.z) * rfv); fv.w = pg8::cvt_pk_safe(bflo(rv.w) * rfv, bfhi(rv.w) * rfv);
          *(LAS v4u*)(S + SC_V + vrow * SC_VP + 16 * vpc) = fv; }
        *(LAS v4u*)(S + SC_SF + tid * 16) = rs0; if (tid < 128) *(LAS v4u*)(S + SC_SF + (256 + tid) * 16) = rs1;
        *(LAS float*)(S + SC_S + tid * 4) = rx1; if (tid >= 128 && tid < 192) *(LAS float*)(S + SC_S + (128 + tid) * 4) = rx2;
    };
    { const bf16* QKM = WSP(bf16, WS_QKM); const bf16* XM = WSP(bf16, WS_XM);
#pragma unroll
      for (int i = 0; i < 4; ++i) { const int l = row_l(0, qrow0 + 16 * i); rq[i] = (v4u){0, 0, 0, 0}; rk[i] = (v4u){0, 0, 0, 0};
          if (l >= 0) { const bf16* src = QKM + ((size_t)b * LSEQ + l) * 1024 + h * 256 + 8 * qc; rq[i] = *(const GAS v4u*)src; rk[i] = *(const GAS v4u*)(src + 128); } }
      rv = (v4u){0, 0, 0, 0};
      { const int l = row_l(0, vrow); if (l >= 0) rv = *(const GAS v4u*)(XM + ((size_t)b * LSEQ + l) * 1024 + h * 256 + 32 * sl + 8 * vpc); }
      { const float x1 = (farr == 0 ? SG : SPM)[ft], x2 = (farr == 3) ? SB[ft] : 0.f;
        const float mc = ((const LAS float*)(lds + SC_MC))[0], M63 = ((const LAS float*)(lds + SC_MC))[68], Mt = fmaxf(mc, x1);
        if (farr == 0) rx1 = __expf(x1 - M63); else if (farr == 1) rx1 = __expf(fminf(M63 - Mt, 80.f)); else if (farr == 2) rx1 = __expf(mc - Mt); else rx1 = __expf(-(x2 + Mt));
        rfv = __expf(SG[vrow] - M63);
        if (dir && tid >= 128 && tid < 192) rx2 = facb[128 + tid]; }
      rs0 = (v4u){0, 0, 0, 0}; if (dir) { rs0 = *(const GAS v4u*)sfp; if (tid < 128) rs1 = *(const GAS v4u*)(sfp + 256); }
      commit(0, 0); }
    __syncthreads();
    f32x4 Cs[2][2], Ns[2];
#pragma unroll
    for (int i = 0; i < 2; ++i) { Ns[i] = (f32x4){0.f, 0.f, 0.f, 0.f}; Cs[0][i] = Ns[i]; Cs[1][i] = Ns[i]; }
    const int ktr_off = (8 * g + (c16 >> 2)) * SC_QP + 8 * (c16 & 3) + 32 * (2 * wid);
    const int vtr_off = ((c16 >> 2)) * SC_VP + 8 * (c16 & 3);
    for (int c = 0; c < nsteps; ++c) {
        const int st = c & 1;
        if (c + 1 < nsteps) issue(c + 1);
        const LAS unsigned char* S = lds + st * SC_STAGE;
        const LAS unsigned char* Ks = S + SC_K; const LAS unsigned char* Vs = S + SC_V;
        const LAS float* fF = (const LAS float*)(S + SC_S); const LAS float* fW = fF + 128;
        f32x4 gf[2][2]; s16x4 bvlo[2][2], bvhi[2][2], klo[2][2], khi[2][2];
#pragma unroll
        for (int ks = 0; ks < 2; ++ks) { gf[ks][0] = *(const LAS f32x4*)(fF + 32 * ks + 8 * g); gf[ks][1] = *(const LAS f32x4*)(fF + 32 * ks + 8 * g + 4); }
#pragma unroll
        for (int eb = 0; eb < 2; ++eb)
#pragma unroll
            for (int ks = 0; ks < 2; ++ks) { const LAS unsigned char* va = Vs + vtr_off + 32 * eb + (32 * ks + 8 * g) * SC_VP; bvlo[eb][ks] = ds_tr16(va); bvhi[eb][ks] = ds_tr16(va + 4 * SC_VP); }
#pragma unroll
        for (int d2 = 0; d2 < 2; ++d2)
#pragma unroll
            for (int ks = 0; ks < 2; ++ks) { const LAS unsigned char* ka = Ks + ktr_off + 32 * ks * SC_QP + 32 * d2; klo[d2][ks] = ds_tr16(ka); khi[d2][ks] = ds_tr16(ka + 4 * SC_QP); }
        const float decay = fW[63];
        SCHED_FENCE();
        bf16x8 Bf[2][2], Fb[2];
#pragma unroll
        for (int ks = 0; ks < 2; ++ks) { float ff[8];
#pragma unroll
            for (int j = 0; j < 4; ++j) { ff[j] = gf[ks][0][j]; ff[4 + j] = gf[ks][1][j]; }
            Fb[ks] = pack8(ff);
#pragma unroll
            for (int eb = 0; eb < 2; ++eb) Bf[eb][ks] = cat8(bvlo[eb][ks], bvhi[eb][ks]); }
#pragma unroll
        for (int d2 = 0; d2 < 2; ++d2) { Cs[0][d2] *= decay; Cs[1][d2] *= decay; Ns[d2] *= decay; }
#pragma unroll
        for (int ks = 0; ks < 2; ++ks)
#pragma unroll
            for (int d2 = 0; d2 < 2; ++d2) { const bf16x8 A = cat8(klo[d2][ks], khi[d2][ks]);
                Cs[0][d2] = __builtin_amdgcn_mfma_f32_16x16x32_bf16(A, Bf[0][ks], Cs[0][d2], 0, 0, 0);
                Cs[1][d2] = __builtin_amdgcn_mfma_f32_16x16x32_bf16(A, Bf[1][ks], Cs[1][d2], 0, 0, 0);
                Ns[d2] = __builtin_amdgcn_mfma_f32_16x16x32_bf16(A, Fb[ks], Ns[d2], 0, 0, 0); }
#pragma unroll
        for (int eb = 0; eb < 2; ++eb) { const float cfv[8] = {Cs[eb][0][0], Cs[eb][0][1], Cs[eb][0][2], Cs[eb][0][3], Cs[eb][1][0], Cs[eb][1][1], Cs[eb][1][2], Cs[eb][1][3]};
            *(LAS bf16x8*)(lds + SC_CIMG + (st ^ 1) * 8192 + (eb * 4 + wid) * 1024 + lane * 16) = pack8(cfv); }
        { const float nfv[8] = {Ns[0][0], Ns[0][1], Ns[0][2], Ns[0][3], Ns[1][0], Ns[1][1], Ns[1][2], Ns[1][3]};
          *(LAS bf16x8*)(lds + SC_NIMG + (st ^ 1) * 4096 + wid * 1024 + lane * 16) = pack8(nfv); }
        if (c + 1 < nsteps) commit(c + 1, st ^ 1);
        asm volatile("s_waitcnt lgkmcnt(0)" ::: "memory"); __builtin_amdgcn_s_barrier(); asm volatile("" ::: "memory");
    }
}
template <int TB>
__device__ __forceinline__ void scan_A(const Ptrs& p, LAS unsigned char* lds, int item, int lane) {
    using pg8::f32x4;
    const int seq = item >> 3, sl = item & 7, dir = seq & 1, h = (seq >> 1) & 3, b = seq >> 3;
    const int nsteps = dir ? 64 : 65;
    const int c16 = lane & 15, g = lane >> 4;
    auto row_l = [&](int c, int t) -> int { return dir ? (LSEQ - 1 - 64 * c - t) : (64 * c + t - 48); };
    __syncthreads();
    const int qrow_off = (16 * TB + c16) * SC_QP;
    const int vtr_off = ((c16 >> 2)) * SC_VP + 8 * (c16 & 3);
    bf16* hop = (dir ? WSP(bf16, WS_HB) : WSP(bf16, WS_HF)) + ((size_t)b * SEQ + (row_l(1, 16 * TB + c16) - NMETA)) * 1024 + h * 256 + 32 * sl + 4 * g;
    const long long rstep = dir ? -64 : 64;
    constexpr int NK2 = (TB >= 2) ? 2 : 1;
    for (int c = 0; c < nsteps; ++c) {
        const int st = c & 1;
        const LAS unsigned char* S = lds + st * SC_STAGE;
        const LAS unsigned char* Qs = S + SC_Q; const LAS unsigned char* Vs = S + SC_V;
        const LAS float* fF = (const LAS float*)(S + SC_S); const LAS float* fR = fF + 64; const LAS float* fW = fF + 128; const LAS float* fE = fF + 192; const LAS float* fQ = fF + 256;
        bf16x8 cf[2][4], nf[4], sfr[NK2]; v2u qlo[4], qhi[4]; s16x4 svlo[2][NK2], svhi[2][NK2];
#pragma unroll
        for (int kk = 0; kk < 4; ++kk) { cf[0][kk] = *(const LAS bf16x8*)(lds + SC_CIMG + st * 8192 + kk * 1024 + lane * 16); cf[1][kk] = *(const LAS bf16x8*)(lds + SC_CIMG + st * 8192 + (4 + kk) * 1024 + lane * 16);
            nf[kk] = *(const LAS bf16x8*)(lds + SC_NIMG + st * 4096 + kk * 1024 + lane * 16); }
#pragma unroll
        for (int kk = 0; kk < 4; ++kk) { qlo[kk] = *(const LAS v2u*)(Qs + qrow_off + 64 * kk + 8 * g); qhi[kk] = *(const LAS v2u*)(Qs + qrow_off + 64 * kk + 32 + 8 * g); }
#pragma unroll
        for (int k2 = 0; k2 < NK2; ++k2) sfr[k2] = *(const LAS bf16x8*)(S + SC_SF + (SF_BASE(TB) + k2) * 1024 + lane * 16);
#pragma unroll
        for (int eb = 0; eb < 2; ++eb)
#pragma unroll
            for (int k2 = 0; k2 < NK2; ++k2) { const LAS unsigned char* va = Vs + vtr_off + 32 * eb + (32 * k2 + 4 * g) * SC_VP; svlo[eb][k2] = ds_tr16(va); svhi[eb][k2] = ds_tr16(va + 16 * SC_VP); }
        const float Rt = fR[16 * TB + c16], Wt = fW[16 * TB + c16], Et = fE[16 * TB + c16], Qt = fQ[16 * TB + c16];
        SCHED_FENCE();
        f32x4 P0 = (f32x4){0.f, 0.f, 0.f, 0.f}, P1 = P0, Pn = P0, Sv0 = P0, Sv1 = P0;
#pragma unroll
        for (int kk = 0; kk < 4; ++kk) { const bf16x8 A = __builtin_bit_cast(bf16x8, (v4u){qlo[kk].x, qlo[kk].y, qhi[kk].x, qhi[kk].y});
            P0 = __builtin_amdgcn_mfma_f32_16x16x32_bf16(cf[0][kk], A, P0, 0, 0, 0); P1 = __builtin_amdgcn_mfma_f32_16x16x32_bf16(cf[1][kk], A, P1, 0, 0, 0);
            Pn = __builtin_amdgcn_mfma_f32_16x16x32_bf16(nf[kk], A, Pn, 0, 0, 0); }
#pragma unroll
        for (int k2 = 0; k2 < NK2; ++k2) {
            Sv0 = __builtin_amdgcn_mfma_f32_16x16x32_bf16(cat8(svlo[0][k2], svhi[0][k2]), sfr[k2], Sv0, 0, 0, 0);
            Sv1 = __builtin_amdgcn_mfma_f32_16x16x32_bf16(cat8(svlo[1][k2], svhi[1][k2]), sfr[k2], Sv1, 0, 0, 0); }
        if (!(dir == 0 && c == 0)) {
            bf16* op = hop + (long long)(c - 1) * rstep * 1024;
            const float den = Wt * Pn[0] + Qt, inv = __builtin_amdgcn_rcpf(fmaxf(fabsf(den), Et)), wi = Wt * inv, ri = Rt * inv;
            v2u o0, o1;
            o0.x = pg8::cvt_pk_safe(wi * P0[0] + ri * Sv0[0], wi * P0[1] + ri * Sv0[1]); o0.y = pg8::cvt_pk_safe(wi * P0[2] + ri * Sv0[2], wi * P0[3] + ri * Sv0[3]);
            o1.x = pg8::cvt_pk_safe(wi * P1[0] + ri * Sv1[0], wi * P1[1] + ri * Sv1[1]); o1.y = pg8::cvt_pk_safe(wi * P1[2] + ri * Sv1[2], wi * P1[3] + ri * Sv1[3]);
            *(GAS v2u*)op = o0; *(GAS v2u*)(op + 16) = o1; }
        asm volatile("s_waitcnt lgkmcnt(0)" ::: "memory"); __builtin_amdgcn_s_barrier(); asm volatile("" ::: "memory");
    }
}
__device__ __forceinline__ void scan_zero_images(LAS unsigned char* lds, int tid) { for (int i = tid; i < (16384 + 8192) / 4; i += NTHR) *(LAS unsigned*)(lds + SC_CIMG + i * 4) = 0u; }
__device__ __forceinline__ void scan_item(const Ptrs& p, LAS unsigned char* lds, int item, int tid, int wid, int lane, int flags) {
    (void)flags;
    switch (wid) {
        case 0: case 1: case 2: case 3: scan_B(p, lds, item, tid, wid, lane); break;
        case 4: scan_A<0>(p, lds, item, lane); break;
        case 5: scan_A<1>(p, lds, item, lane); break;
        case 6: scan_A<2>(p, lds, item, lane); break;
        default: scan_A<3>(p, lds, item, lane); break;
    }
}

constexpr int NA_KR = 0, NA_VR = 65536, NA_KM = 131072, NA_VM = 133120, NA_RPB = 135168;
static_assert(NA_RPB + 4 * 15 * 32 * 4 <= LDSCTL_OFF, "NA LDS");
__device__ __forceinline__ int na_r0(int r) { return min(max(r - 4, 0), 56); }
__device__ __forceinline__ void na_block(const Ptrs& p, LAS unsigned char* lds, int item, int tid, int wave, int lane) {
    using pg8::f32x4;
    const int rb = item & 7, bh = item >> 3, h = bh & 7, b = bh >> 3;
    const int c16 = lane & 15, g = lane >> 4, seg = wave & 3, eh = wave >> 2;
    const bf16* QN = WSP(bf16, WS_QN); const bf16* KN = WSP(bf16, WS_KN); const bf16* VR = WSP(bf16, WS_VR); bf16* YB = WSP(bf16, WS_YB);
    const int st_r = tid >> 3, st_c = tid & 7;
    const int st_dst = st_r * 128 + ((st_c ^ ((st_r >> 1) & 7)) << 4);
    const bf16* ksrc = KN + ((size_t)b * LSEQ + NMETA + st_r) * NAI + h * 64 + 8 * st_c;
    const bf16* vsrc = VR + ((size_t)b * LSEQ + NMETA + st_r) * NAI + h * 64 + 8 * st_c;
    if (tid < 128) *(LAS v4u*)(lds + NA_KM + st_dst) = *(const GAS v4u*)(KN + ((size_t)b * LSEQ + st_r) * NAI + h * 64 + 8 * st_c);
    else if (tid < 256) { const int t2 = tid - 128; *(LAS v4u*)(lds + NA_VM + (t2 >> 3) * 128 + (((t2 & 7) ^ (((t2 >> 3) >> 1) & 7)) << 4)) = *(const GAS v4u*)(VR + ((size_t)b * LSEQ + (t2 >> 3)) * NAI + h * 64 + 8 * (t2 & 7)); }
    for (int i = tid; i < 4 * 15 * 32; i += NTHR) { const int s = i / 480, rem = i - s * 480, dr = rem >> 5, j = (rem & 31) + s;
        ((LAS float*)(lds + NA_RPB))[i] = (j < 31) ? p.rpb[h * 465 + dr * 31 + j] * 1.4426950408889634f : 0.f; }
    const int rfirst = 8 * rb, w0 = na_r0(rfirst);
#pragma unroll
    for (int half = 0; half < 2; ++half) {
        v4u kq[4], vq[4];
#pragma unroll
        for (int j = 0; j < 4; ++j) { const int kr = w0 + 4 * half + j; kq[j] = *(const GAS v4u*)(ksrc + (size_t)kr * 64 * NAI); vq[j] = *(const GAS v4u*)(vsrc + (size_t)kr * 64 * NAI); }
#pragma unroll
        for (int j = 0; j < 4; ++j) { const int sl = (w0 + 4 * half + j) & 7; *(LAS v4u*)(lds + NA_KR + sl * 8192 + st_dst) = kq[j]; *(LAS v4u*)(lds + NA_VR + sl * 8192 + st_dst) = vq[j]; }
    }
    __syncthreads();
    const int reg0 = min(max(16 * seg - 8, 0), 32);
    const int qcol = 16 * seg + c16, win0 = min(max(qcol - 8, 0), 48);
    const int dcb = reg0 + 4 * g - qcol + 15, bsh = dcb & 3;
    const LAS unsigned char* bias_base = lds + NA_RPB + (bsh * 480 + (dcb - bsh)) * 4;
    unsigned vmask = 0u;
#pragma unroll
    for (int ct = 0; ct < 2; ++ct)
#pragma unroll
        for (int q = 0; q < 4; ++q) { const int kcol = reg0 + 16 * ct + 4 * g + q; if (kcol >= win0 && kcol < win0 + 16) vmask |= 1u << (4 * ct + q); }
    float mb4[4];
#pragma unroll
    for (int q = 0; q < 4; ++q) mb4[q] = p.mbias[h * 16 + 4 * g + q] * 1.4426950408889634f;
    int koff[2][2];
#pragma unroll
    for (int ct = 0; ct < 2; ++ct)
#pragma unroll
        for (int ks = 0; ks < 2; ++ks) { const int tok = reg0 + 16 * ct + c16; koff[ct][ks] = tok * 128 + (((g + 4 * ks) ^ ((tok >> 1) & 7)) << 4); }
    int voff[2][2];
#pragma unroll
    for (int e2 = 0; e2 < 2; ++e2)
#pragma unroll
        for (int hl = 0; hl < 2; ++hl) { const int tok = reg0 + 16 * hl + 4 * g + (c16 >> 2), ch = 2 * (2 * eh + e2) + ((c16 & 3) >> 1); voff[e2][hl] = tok * 128 + ((ch ^ ((tok >> 1) & 7)) << 4) + 8 * (c16 & 1); }
    int vmoff[2];
#pragma unroll
    for (int e2 = 0; e2 < 2; ++e2) { const int tok = 4 * g + (c16 >> 2), ch = 2 * (2 * eh + e2) + ((c16 & 3) >> 1); vmoff[e2] = tok * 128 + ((ch ^ ((tok >> 1) & 7)) << 4) + 8 * (c16 & 1); }
    const int kmoff0 = c16 * 128 + ((g ^ ((c16 >> 1) & 7)) << 4), kmoff1 = c16 * 128 + (((g + 4) ^ ((c16 >> 1) & 7)) << 4);
    bf16x8 qn_[2];
    { const bf16* qp = QN + ((size_t)b * LSEQ + NMETA + rfirst * 64 + qcol) * NAI + h * 64 + 8 * g; qn_[0] = *(const GAS bf16x8*)qp; qn_[1] = *(const GAS bf16x8*)(qp + 32); }
    for (int rr8 = 0; rr8 < 8; ++rr8) {
        const int r = rfirst + rr8, r0 = na_r0(r);
        const bool have_new = (rr8 < 7) && (na_r0(r + 1) != r0);
        const int newrow = r0 + 8;
        v4u nk = {0, 0, 0, 0}, nv = {0, 0, 0, 0};
        if (have_new) { nk = *(const GAS v4u*)(ksrc + (size_t)newrow * 64 * NAI); nv = *(const GAS v4u*)(vsrc + (size_t)newrow * 64 * NAI); }
        const bf16x8 qf[2] = {qn_[0], qn_[1]};
        if (rr8 < 7) { const bf16* qp = QN + ((size_t)b * LSEQ + NMETA + (r + 1) * 64 + qcol) * NAI + h * 64 + 8 * g; qn_[0] = *(const GAS bf16x8*)qp; qn_[1] = *(const GAS bf16x8*)(qp + 32); }
        f32x4 X[17];
#pragma unroll
        for (int kr = 0; kr < 8; ++kr) { const LAS unsigned char* ks_ = lds + NA_KR + ((r0 + kr) & 7) * 8192;
#pragma unroll
            for (int ct = 0; ct < 2; ++ct) { const bf16x8 k0 = *(const LAS bf16x8*)(ks_ + koff[ct][0]), k1 = *(const LAS bf16x8*)(ks_ + koff[ct][1]);
                f32x4 x = __builtin_amdgcn_mfma_f32_16x16x32_bf16(k0, qf[0], (f32x4){0.f, 0.f, 0.f, 0.f}, 0, 0, 0);
                X[2 * kr + ct] = __builtin_amdgcn_mfma_f32_16x16x32_bf16(k1, qf[1], x, 0, 0, 0); } }
        { const bf16x8 k0 = *(const LAS bf16x8*)(lds + NA_KM + kmoff0), k1 = *(const LAS bf16x8*)(lds + NA_KM + kmoff1);
          f32x4 x = __builtin_amdgcn_mfma_f32_16x16x32_bf16(k0, qf[0], (f32x4){0.f, 0.f, 0.f, 0.f}, 0, 0, 0);
          X[16] = __builtin_amdgcn_mfma_f32_16x16x32_bf16(k1, qf[1], x, 0, 0, 0); }
        float mx = -INFINITY;
        const LAS unsigned char* brow = bias_base + (r0 - r + 7) * 128;
#pragma unroll
        for (int i = 0; i < 16; ++i) { const f32x4 bv = *(const LAS f32x4*)(brow + (i >> 1) * 128 + (i & 1) * 64);
#pragma unroll
            for (int q = 0; q < 4; ++q) { const float v = ((vmask >> (4 * (i & 1) + q)) & 1u) ? X[i][q] + bv[q] : -INFINITY; X[i][q] = v; mx = fmaxf(mx, v); } }
#pragma unroll
        for (int q = 0; q < 4; ++q) { const float v = X[16][q] + mb4[q]; X[16][q] = v; mx = fmaxf(mx, v); }
        mx = fmaxf(mx, __shfl_xor(mx, 16)); mx = fmaxf(mx, __shfl_xor(mx, 32));
        float sum = 0.f;
#pragma unroll
        for (int i = 0; i < 17; ++i)
#pragma unroll
            for (int q = 0; q < 4; ++q) { const float e = __builtin_amdgcn_exp2f(X[i][q] - mx); X[i][q] = e; sum += e; }
        sum += __shfl_xor(sum, 16); sum += __shfl_xor(sum, 32);
        const float inv = 1.0f / sum;
        f32x4 O[2] = {(f32x4){0.f, 0.f, 0.f, 0.f}, (f32x4){0.f, 0.f, 0.f, 0.f}};
#pragma unroll
        for (int kk = 0; kk < 8; ++kk) {
            float pf[8];
#pragma unroll
            for (int j = 0; j < 4; ++j) { pf[j] = X[2 * kk][j]; pf[4 + j] = X[2 * kk + 1][j]; }
            const bf16x8 A = pack8(pf);
            const LAS unsigned char* vs_ = lds + NA_VR + ((r0 + kk) & 7) * 8192;
#pragma unroll
            for (int e2 = 0; e2 < 2; ++e2) { const s16x4 lo = ds_tr16(vs_ + voff[e2][0]), hi = ds_tr16(vs_ + voff[e2][1]);
                O[e2] = __builtin_amdgcn_mfma_f32_16x16x32_bf16(A, cat8(lo, hi), O[e2], 0, 0, 0); } }
        { float pf[8];
#pragma unroll
          for (int j = 0; j < 4; ++j) { pf[j] = X[16][j]; pf[4 + j] = 0.f; }
          const bf16x8 A = pack8(pf);
#pragma unroll
          for (int e2 = 0; e2 < 2; ++e2) { const s16x4 lo = ds_tr16(lds + NA_VM + vmoff[e2]); const s16x4 z = {0, 0, 0, 0};
              O[e2] = __builtin_amdgcn_mfma_f32_16x16x32_bf16(A, cat8(lo, z), O[e2], 0, 0, 0); } }
#pragma unroll
        for (int q = 0; q < 4; ++q) { const float iv = __shfl(inv, 4 * g + q); bf16* op = YB + ((size_t)b * SEQ + r * 64 + 16 * seg + 4 * g + q) * NAI + h * 64 + 32 * eh + c16;
            op[0] = (bf16)f2bf(O[0][q] * iv); op[16] = (bf16)f2bf(O[1][q] * iv); }
        __syncthreads();
        if (have_new) { const int sl = newrow & 7; *(LAS v4u*)(lds + NA_KR + sl * 8192 + st_dst) = nk; *(LAS v4u*)(lds + NA_VR + sl * 8192 + st_dst) = nv; }
        __syncthreads();
    }
}

__device__ __forceinline__ void na_sync4(LAS unsigned* cnt, unsigned& epoch, int lane) {
    epoch += 4u;
    asm volatile("s_waitcnt lgkmcnt(0)" ::: "memory");
    if (lane == 0) __hip_atomic_fetch_add(cnt, 1u, __ATOMIC_RELAXED, __HIP_MEMORY_SCOPE_WORKGROUP);
    unsigned sp = 0;
    while ((unsigned)__builtin_amdgcn_readfirstlane((int)__hip_atomic_load(cnt, __ATOMIC_RELAXED, __HIP_MEMORY_SCOPE_WORKGROUP)) < epoch) { __builtin_amdgcn_s_sleep(0); if (++sp > (1u << 24)) break; }
    asm volatile("" ::: "memory");
}
__device__ __forceinline__ void na_block4(const Ptrs& p, LAS unsigned char* lds, int item, int tid4, int seg, int lane) {
    using pg8::f32x4;
    const int rb = item & 7, bh = item >> 3, h = bh & 7, b = bh >> 3;
    const int c16 = lane & 15, g = lane >> 4;
    LAS unsigned* cnt = (LAS unsigned*)(lds + MISC_OFF + 64); unsigned epoch = 0u;
    const bf16* QN = WSP(bf16, WS_QN); const bf16* KN = WSP(bf16, WS_KN); const bf16* VR = WSP(bf16, WS_VR); bf16* YB = WSP(bf16, WS_YB);
    const int st_r = tid4 >> 3, st_c = tid4 & 7;
    const int st_dst = st_r * 128 + ((st_c ^ ((st_r >> 1) & 7)) << 4), st_dst2 = (st_r + 32) * 128 + ((st_c ^ (((st_r + 32) >> 1) & 7)) << 4);
    const size_t st_2nd = (size_t)32 * NAI;
    const bf16* ksrc = KN + ((size_t)b * LSEQ + NMETA + st_r) * NAI + h * 64 + 8 * st_c;
    const bf16* vsrc = VR + ((size_t)b * LSEQ + NMETA + st_r) * NAI + h * 64 + 8 * st_c;
    if (tid4 < 128) *(LAS v4u*)(lds + NA_KM + st_dst) = *(const GAS v4u*)(KN + ((size_t)b * LSEQ + st_r) * NAI + h * 64 + 8 * st_c);
    { const int t2 = tid4 & 127; if (tid4 >= 128) *(LAS v4u*)(lds + NA_VM + (t2 >> 3) * 128 + (((t2 & 7) ^ (((t2 >> 3) >> 1) & 7)) << 4)) = *(const GAS v4u*)(VR + ((size_t)b * LSEQ + (t2 >> 3)) * NAI + h * 64 + 8 * (t2 & 7)); }
    for (int i = tid4; i < 4 * 15 * 32; i += 256) { const int s = i / 480, rem = i - s * 480, dr = rem >> 5, j = (rem & 31) + s;
        ((LAS float*)(lds + NA_RPB))[i] = (j < 31) ? p.rpb[h * 465 + dr * 31 + j] * 1.4426950408889634f : 0.f; }
    const int rfirst = 8 * rb, w0 = na_r0(rfirst);
    { v4u kq[8][2];
#pragma unroll
      for (int j = 0; j < 8; ++j) { const int kr = w0 + j; kq[j][0] = *(const GAS v4u*)(ksrc + (size_t)kr * 64 * NAI); kq[j][1] = *(const GAS v4u*)(ksrc + (size_t)kr * 64 * NAI + st_2nd); }
      __builtin_amdgcn_sched_barrier(0);
#pragma unroll
      for (int j = 0; j < 8; ++j) { const int sl = (w0 + j) & 7; *(LAS v4u*)(lds + NA_KR + sl * 8192 + st_dst) = kq[j][0]; *(LAS v4u*)(lds + NA_KR + sl * 8192 + st_dst2) = kq[j][1]; } }
    { v4u vq[8][2];
#pragma unroll
      for (int j = 0; j < 8; ++j) { const int kr = w0 + j; vq[j][0] = *(const GAS v4u*)(vsrc + (size_t)kr * 64 * NAI); vq[j][1] = *(const GAS v4u*)(vsrc + (size_t)kr * 64 * NAI + st_2nd); }
      __builtin_amdgcn_sched_barrier(0);
#pragma unroll
      for (int j = 0; j < 8; ++j) { const int sl = (w0 + j) & 7; *(LAS v4u*)(lds + NA_VR + sl * 8192 + st_dst) = vq[j][0]; *(LAS v4u*)(lds + NA_VR + sl * 8192 + st_dst2) = vq[j][1]; } }
    na_sync4(cnt, epoch, lane);
    const int reg0 = min(max(16 * seg - 8, 0), 32);
    const int qcol = 16 * seg + c16, win0 = min(max(qcol - 8, 0), 48);
    const int dcb = reg0 + 4 * g - qcol + 15, bsh = dcb & 3;
    const LAS unsigned char* bias_base = lds + NA_RPB + (bsh * 480 + (dcb - bsh)) * 4;
    unsigned vmask = 0u;
#pragma unroll
    for (int ct = 0; ct < 2; ++ct)
#pragma unroll
        for (int q = 0; q < 4; ++q) { const int kcol = reg0 + 16 * ct + 4 * g + q; if (kcol >= win0 && kcol < win0 + 16) vmask |= 1u << (4 * ct + q); }
    float mb4[4];
#pragma unroll
    for (int q = 0; q < 4; ++q) mb4[q] = p.mbias[h * 16 + 4 * g + q] * 1.4426950408889634f;
    int koff[2][2];
#pragma unroll
    for (int ct = 0; ct < 2; ++ct)
#pragma unroll
        for (int ks = 0; ks < 2; ++ks) { const int tok = reg0 + 16 * ct + c16; koff[ct][ks] = tok * 128 + (((g + 4 * ks) ^ ((tok >> 1) & 7)) << 4); }
    int voff[4][2];
#pragma unroll
    for (int e2 = 0; e2 < 4; ++e2)
#pragma unroll
        for (int hl = 0; hl < 2; ++hl) { const int tok = reg0 + 16 * hl + 4 * g + (c16 >> 2), ch = 2 * e2 + ((c16 & 3) >> 1); voff[e2][hl] = tok * 128 + ((ch ^ ((tok >> 1) & 7)) << 4) + 8 * (c16 & 1); }
    int vmoff[4];
#pragma unroll
    for (int e2 = 0; e2 < 4; ++e2) { const int tok = 4 * g + (c16 >> 2), ch = 2 * e2 + ((c16 & 3) >> 1); vmoff[e2] = tok * 128 + ((ch ^ ((tok >> 1) & 7)) << 4) + 8 * (c16 & 1); }
    const int kmoff0 = c16 * 128 + ((g ^ ((c16 >> 1) & 7)) << 4), kmoff1 = c16 * 128 + (((g + 4) ^ ((c16 >> 1) & 7)) << 4);
    bf16x8 qn_[2];
    { const bf16* qp = QN + ((size_t)b * LSEQ + NMETA + rfirst * 64 + qcol) * NAI + h * 64 + 8 * g; qn_[0] = *(const GAS bf16x8*)qp; qn_[1] = *(const GAS bf16x8*)(qp + 32); }
    for (int rr8 = 0; rr8 < 8; ++rr8) {
        const int r = rfirst + rr8, r0 = na_r0(r);
        const bool have_new = (rr8 < 7) && (na_r0(r + 1) != r0);
        const int newrow = r0 + 8;
        v4u nk = {0, 0, 0, 0}, nv = {0, 0, 0, 0}, nk2 = {0, 0, 0, 0}, nv2 = {0, 0, 0, 0};
        if (have_new) { nk = *(const GAS v4u*)(ksrc + (size_t)newrow * 64 * NAI); nv = *(const GAS v4u*)(vsrc + (size_t)newrow * 64 * NAI); nk2 = *(const GAS v4u*)(ksrc + (size_t)newrow * 64 * NAI + st_2nd); nv2 = *(const GAS v4u*)(vsrc + (size_t)newrow * 64 * NAI + st_2nd); }
        const bf16x8 qf[2] = {qn_[0], qn_[1]};
        if (rr8 < 7) { const bf16* qp = QN + ((size_t)b * LSEQ + NMETA + (r + 1) * 64 + qcol) * NAI + h * 64 + 8 * g; qn_[0] = *(const GAS bf16x8*)qp; qn_[1] = *(const GAS bf16x8*)(qp + 32); }
        f32x4 X[17];
        bf16x8 kfa[2][2][2], kfb[2][2][2];
        auto ldk = [&](bf16x8 (&kf)[2][2][2], int kp) {
#pragma unroll
            for (int k1 = 0; k1 < 2; ++k1) { const LAS unsigned char* ks_ = lds + NA_KR + ((r0 + 2 * kp + k1) & 7) * 8192;
#pragma unroll
                for (int ct = 0; ct < 2; ++ct) { kf[k1][ct][0] = *(const LAS bf16x8*)(ks_ + koff[ct][0]); kf[k1][ct][1] = *(const LAS bf16x8*)(ks_ + koff[ct][1]); } } };
        auto mmk = [&](const bf16x8 (&kf)[2][2][2], int kp) {
#pragma unroll
            for (int k1 = 0; k1 < 2; ++k1)
#pragma unroll
                for (int ct = 0; ct < 2; ++ct) { f32x4 x = __builtin_amdgcn_mfma_f32_16x16x32_bf16(kf[k1][ct][0], qf[0], (f32x4){0.f, 0.f, 0.f, 0.f}, 0, 0, 0);
                    X[2 * (2 * kp + k1) + ct] = __builtin_amdgcn_mfma_f32_16x16x32_bf16(kf[k1][ct][1], qf[1], x, 0, 0, 0); } };
        ldk(kfa, 0); __builtin_amdgcn_sched_barrier(0);
        ldk(kfb, 1); mmk(kfa, 0); __builtin_amdgcn_sched_barrier(0);
        ldk(kfa, 2); mmk(kfb, 1); __builtin_amdgcn_sched_barrier(0);
        ldk(kfb, 3); mmk(kfa, 2); __builtin_amdgcn_sched_barrier(0);
        const bf16x8 km0 = *(const LAS bf16x8*)(lds + NA_KM + kmoff0), km1 = *(const LAS bf16x8*)(lds + NA_KM + kmoff1);
        const LAS unsigned char* brow = bias_base + (r0 - r + 7) * 128;
        f32x4 bv16[16];
#pragma unroll
        for (int i = 0; i < 16; ++i) bv16[i] = *(const LAS f32x4*)(brow + (i >> 1) * 128 + (i & 1) * 64);
        s16x4 vla[2][4], vha[2][4], vlb[2][4], vhb[2][4];
        auto ldv = [&](s16x4 (&vl)[2][4], s16x4 (&vh)[2][4], int kp) {
#pragma unroll
            for (int k1 = 0; k1 < 2; ++k1) { const LAS unsigned char* vs_ = lds + NA_VR + ((r0 + 2 * kp + k1) & 7) * 8192;
#pragma unroll
                for (int e2 = 0; e2 < 4; ++e2) { vl[k1][e2] = ds_tr16(vs_ + voff[e2][0]); vh[k1][e2] = ds_tr16(vs_ + voff[e2][1]); } } };
        ldv(vla, vha, 0);
        mmk(kfb, 3);
        { f32x4 x = __builtin_amdgcn_mfma_f32_16x16x32_bf16(km0, qf[0], (f32x4){0.f, 0.f, 0.f, 0.f}, 0, 0, 0); X[16] = __builtin_amdgcn_mfma_f32_16x16x32_bf16(km1, qf[1], x, 0, 0, 0); }
        __builtin_amdgcn_sched_barrier(0);
        float mx = -INFINITY;
#pragma unroll
        for (int i = 0; i < 16; ++i) { const f32x4 bv = bv16[i];
#pragma unroll
            for (int q = 0; q < 4; ++q) { const float v = ((vmask >> (4 * (i & 1) + q)) & 1u) ? X[i][q] + bv[q] : -INFINITY; X[i][q] = v; mx = fmaxf(mx, v); } }
#pragma unroll
        for (int q = 0; q < 4; ++q) { const float v = X[16][q] + mb4[q]; X[16][q] = v; mx = fmaxf(mx, v); }
        mx = fmaxf(mx, __shfl_xor(mx, 16)); mx = fmaxf(mx, __shfl_xor(mx, 32));
        float sum = 0.f;
#pragma unroll
        for (int i = 0; i < 17; ++i)
#pragma unroll
            for (int q = 0; q < 4; ++q) { const float e = __builtin_amdgcn_exp2f(X[i][q] - mx); X[i][q] = e; sum += e; }
        sum += __shfl_xor(sum, 16); sum += __shfl_xor(sum, 32);
        const float inv = 1.0f / sum;
        f32x4 O[4] = {(f32x4){0.f, 0.f, 0.f, 0.f}, (f32x4){0.f, 0.f, 0.f, 0.f}, (f32x4){0.f, 0.f, 0.f, 0.f}, (f32x4){0.f, 0.f, 0.f, 0.f}};
        auto mmv = [&](const s16x4 (&vl)[2][4], const s16x4 (&vh)[2][4], int kp) {
#pragma unroll
            for (int k1 = 0; k1 < 2; ++k1) { const int kk = 2 * kp + k1; float pf[8];
#pragma unroll
                for (int j = 0; j < 4; ++j) { pf[j] = X[2 * kk][j]; pf[4 + j] = X[2 * kk + 1][j]; }
                const bf16x8 A = pack8(pf);
#pragma unroll
                for (int e2 = 0; e2 < 4; ++e2) O[e2] = __builtin_amdgcn_mfma_f32_16x16x32_bf16(cat8(vl[k1][e2], vh[k1][e2]), A, O[e2], 0, 0, 0); } };
        __builtin_amdgcn_sched_barrier(0);
        ldv(vlb, vhb, 1); mmv(vla, vha, 0); __builtin_amdgcn_sched_barrier(0);
        ldv(vla, vha, 2); mmv(vlb, vhb, 1); __builtin_amdgcn_sched_barrier(0);
        ldv(vlb, vhb, 3); mmv(vla, vha, 2); __builtin_amdgcn_sched_barrier(0);
        mmv(vlb, vhb, 3);
        { float pf[8];
#pragma unroll
          for (int j = 0; j < 4; ++j) { pf[j] = X[16][j]; pf[4 + j] = 0.f; }
          const bf16x8 A = pack8(pf);
#pragma unroll
          for (int e2 = 0; e2 < 4; ++e2) { const s16x4 lo = ds_tr16(lds + NA_VM + vmoff[e2]); const s16x4 z = {0, 0, 0, 0};
              O[e2] = __builtin_amdgcn_mfma_f32_16x16x32_bf16(cat8(lo, z), A, O[e2], 0, 0, 0); } }
        na_sync4(cnt, epoch, lane);
        if (have_new) { const int sl = newrow & 7; *(LAS v4u*)(lds + NA_KR + sl * 8192 + st_dst) = nk; *(LAS v4u*)(lds + NA_VR + sl * 8192 + st_dst) = nv;
            *(LAS v4u*)(lds + NA_KR + sl * 8192 + st_dst2) = nk2; *(LAS v4u*)(lds + NA_VR + sl * 8192 + st_dst2) = nv2; }
        na_sync4(cnt, epoch, lane);
        { bf16* op = YB + ((size_t)b * SEQ + r * 64 + qcol) * NAI + h * 64 + 4 * g;
#pragma unroll
          for (int e2 = 0; e2 < 4; ++e2) { v2u o; o.x = pg8::cvt_pk_safe(O[e2][0] * inv, O[e2][1] * inv); o.y = pg8::cvt_pk_safe(O[e2][2] * inv, O[e2][3] * inv); *(GAS v2u*)(op + 16 * e2) = o; } }
    }
}

__device__ __forceinline__ void p5_combine(const Ptrs& p, int gw, int NGW, int lane) {
    const bf16* XM = WSP(bf16, WS_XM); const bf16* SO = WSP(bf16, WS_SO); const bf16* HF = WSP(bf16, WS_HF); const bf16* HB = WSP(bf16, WS_HB); bf16* YA = WSP(bf16, WS_YA);
    float cw[3][16], cb[16]; load_conv_w(p, lane, cw, cb);
    float ng[16], sk[16];
#pragma unroll
    for (int q = 0; q < 4; ++q) { const f32x4 a = *(const GAS f32x4*)(p.mnorm_g + 16 * lane + 4 * q), s = *(const GAS f32x4*)(p.mskip + 16 * lane + 4 * q);
        ng[4 * q] = a.x; ng[4 * q + 1] = a.y; ng[4 * q + 2] = a.z; ng[4 * q + 3] = a.w; sk[4 * q] = s.x; sk[4 * q + 1] = s.y; sk[4 * q + 2] = s.z; sk[4 * q + 3] = s.w; }
    for (int tok = gw; tok < MTOK; tok += NGW) {
        const int b = tok >> 12, s = tok & 4095, l = s + NMETA;
        const size_t to = (size_t)tok * 1024 + 16 * lane, ro = ((size_t)b * LSEQ + l) * 1024 + 16 * lane;
        const v4u f0 = *(const GAS v4u*)(HF + to), f1 = *(const GAS v4u*)(HF + to + 8), b0 = *(const GAS v4u*)(HB + to), b1 = *(const GAS v4u*)(HB + to + 8);
        const v4u o0 = *(const GAS v4u*)(SO + ro), o1 = *(const GAS v4u*)(SO + ro + 8);
        float xc[16]; conv_silu16(XM, b, l, lane, cw, cb, xc);
        float hs[16]; float ss = 0.f;
#pragma unroll
        for (int e = 0; e < 4; ++e) { hs[2 * e] = bflo(f0[e]) + bflo(b0[e]); hs[2 * e + 1] = bfhi(f0[e]) + bfhi(b0[e]); hs[8 + 2 * e] = bflo(f1[e]) + bflo(b1[e]); hs[8 + 2 * e + 1] = bfhi(f1[e]) + bfhi(b1[e]); }
#pragma unroll
        for (int j = 0; j < 16; ++j) ss += hs[j] * hs[j];
        ss += __shfl_xor(ss, 1); ss += __shfl_xor(ss, 2); ss += __shfl_xor(ss, 4); ss += __shfl_xor(ss, 8);
        const float rs = 1.0f / sqrtf(ss * (1.f / 256.f) + EPS);
        float so[16];
#pragma unroll
        for (int e = 0; e < 4; ++e) { so[2 * e] = bflo(o0[e]); so[2 * e + 1] = bfhi(o0[e]); so[8 + 2 * e] = bflo(o1[e]); so[8 + 2 * e + 1] = bfhi(o1[e]); }
        float y[16];
#pragma unroll
        for (int j = 0; j < 16; ++j) y[j] = so[j] * (hs[j] * rs * ng[j] + sk[j] * xc[j]);
        v4u w0, w1; w0.x = pk2(y[0], y[1]); w0.y = pk2(y[2], y[3]); w0.z = pk2(y[4], y[5]); w0.w = pk2(y[6], y[7]); w1.x = pk2(y[8], y[9]); w1.y = pk2(y[10], y[11]); w1.z = pk2(y[12], y[13]); w1.w = pk2(y[14], y[15]);
        bf16* yo = YA + (size_t)(lane >> 5) * MTOK * 512 + (size_t)tok * 512 + 16 * (lane & 31);
        *(GAS v4u*)yo = w0; *(GAS v4u*)(yo + 8) = w1;
    }
}

constexpr int NPHASE = 10;
struct Args { Ptrs p; int ph_lo, ph_hi, li, flags; };
__global__ void __launch_bounds__(NTHR, 2) fwd_megakernel(Args args) {
    extern __shared__ __attribute__((aligned(16))) unsigned char lds_raw[];
    LAS unsigned char* lds = (LAS unsigned char*)lds_raw;
    const Ptrs& p = args.p;
    const int G = gridDim.x, bx = blockIdx.x;
    const int vcu = (G % 8 == 0) ? (bx % 8) * (G / 8) + bx / 8 : bx;
    const int NGW = G * NWAVES;
#define IDS() int tid = threadIdx.x; asm volatile("" : "+v"(tid)); const int lane = tid & 63, wave = __builtin_amdgcn_readfirstlane(tid >> 6), gw = vcu * NWAVES + wave; (void)lane; (void)gw
    for (int u = threadIdx.x; u < (LDS_BYTES - LDSCTL_OFF) / 4; u += NTHR) ((LAS unsigned*)(lds + LDSCTL_OFF))[u] = 0u;
    __syncthreads();
    const XcdBarrier bar = xcd_barrier_post((unsigned*)(p.ws + WS_CTL) + CW_BAR + args.li * XCD_BAR_WORDS, (volatile LAS unsigned*)(lds + MISC_OFF) + 8);
    const int lo = args.ph_lo, hi = args.ph_hi;
#define IN(k) (lo <= (k) && (k) < hi)
#define SEAM(k) do { if (IN(k) && IN((k) + 1)) xcd_barrier(bar); } while (0)
#define SEAM2(k, blk) do { if (IN(k) && IN((k) + 1)) { unsigned* const w_ = (unsigned*)(p.ws + WS_CTL) + 16384 + 1088 * (blk); sb_arrive(bar, w_); if (threadIdx.x == 0) sb_wait_lane0(bar, w_); __syncthreads(); } } while (0)

#ifdef MK_XBAR
    for (int i = 0; i < MK_XBAR; ++i) xcd_barrier(bar);
#endif
    unsigned* const sbw01 = (unsigned*)(p.ws + WS_CTL);
    if (IN(0)) { IDS(); p0_prologue<0>(p, lds, gw, NGW, wave, lane);
        if (IN(1)) sb_arrive(bar, sbw01);
        p0_prologue<1>(p, lds, gw, NGW, wave, lane);
        if (IN(1)) { if (threadIdx.x == 0) sb_wait_lane0(bar, sbw01); __syncthreads(); } }

    if (IN(1)) {
        pg8::Gemm g{WSP(bf16, WS_XN), WSP(bf16, WS_WIN), 1024, 1024, 1024, 0, nullptr, nullptr, 1 << 20}; pg8::StaticOrder S; S.init(RP, NIN, G, bx);
        EpiIn E{p.ws, p.out, p.qn_g, p.kn_g};
        pg8::gemm_phase<EpiIn, pg8::StaticOrder, true, true>(lds, g, S, E);
    } SEAM2(1, 1);


    if (IN(3)) {
        { IDS(); pg8::StaticOrder S0; S0.init(MTOK, 1024, G, bx); pg8::Unit u0; if (!S0.next(0, u0)) { u0.pm = 0; u0.pn = 0; }
          p3_head(p, lds, u0.pm, u0.pn, vcu, gw, NGW, wave, lane); }
        { pg8::Gemm g{WSP(bf16, WS_XC), WSP(bf16, WS_WQK), 256, 1024, 256, 256, nullptr, nullptr, 1 << 20}; pg8::StaticOrder S; S.init(MTOK, 1024, G, bx);
          EpiStoreBf16 E{WSP(bf16, WS_QKM), 1024};
          pg8::gemm_phase<EpiStoreBf16, pg8::StaticOrder, true, true>(lds, g, S, E); }
    } SEAM2(3, 2);

    if (IN(4)) {
        IDS();
        __syncthreads();
        scan_setup(p, lds, vcu, wave, lane);
        scan_prepass(p, lds, vcu, wave, lane);
        { unsigned* const w_ = (unsigned*)(p.ws + WS_CTL) + 16384 + 1088 * 3; sb_arrive(bar, w_); scan_zero_images(lds, tid); if (threadIdx.x == 0) sb_wait_lane0(bar, w_); __syncthreads(); }
        if (!(args.flags & 2)) scan_item(p, lds, vcu, tid, wave, lane, args.flags);
    }
    unsigned* const sbw45 = (unsigned*)(p.ws + WS_CTL) + 2240;
    if (IN(4) && IN(5)) sb_arrive(bar, sbw45);

    if (IN(5)) {
        IDS(); __syncthreads();
        const int role_idx = (wave & 1) + 2 * (wave >> 2);
        if (!(wave & 2)) { if (!(args.flags & 4)) na_block4(p, lds, vcu, role_idx * 64 + lane, role_idx, lane); }
        else {
            if (IN(4)) {
                LAS unsigned* flag = (LAS unsigned*)(lds + MISC_OFF + 96);
                if (wave == 2) { if (lane == 0) { sb_wait_lane0(bar, sbw45); __hip_atomic_store(flag, 1u, __ATOMIC_RELAXED, __HIP_MEMORY_SCOPE_WORKGROUP); } }
                unsigned sp = 0;
                while ((unsigned)__builtin_amdgcn_readfirstlane((int)__hip_atomic_load(flag, __ATOMIC_RELAXED, __HIP_MEMORY_SCOPE_WORKGROUP)) == 0u) { __builtin_amdgcn_s_sleep(1); if (++sp > (1u << 24)) break; }
                asm volatile("" ::: "memory");
            }
            p5_combine(p, vcu * 4 + role_idx, G * 4, lane);
        }
    } SEAM2(5, 4);

    if (IN(6)) {
        pg8::Gemm g{WSP(bf16, WS_YA), WSP(bf16, WS_WA), 1536, 512, 1536, 0, WSP(bf16, WS_YA) + (size_t)MTOK * 512, WSP(bf16, WS_YB), 8}; pg8::StaticOrder S; S.init(MTOK, 1024, G, bx);
        EpiMix E{WSP(bf16, WS_MIX), (const bf16*)p.out, (const bf16*)p.out + (size_t)MTOK * 1024};
        pg8::gemm_phase<EpiMix, pg8::StaticOrder, true, true>(lds, g, S, E);
    }
    unsigned* const sbw67 = (unsigned*)(p.ws + WS_CTL) + 1088;
    if (IN(6) && IN(7)) sb_arrive(bar, sbw67);

    if (IN(7)) {
        { IDS(); p_ffw<0>(p, lds, gw, NGW, wave, lane); }
        if (IN(6)) { if (threadIdx.x == 0) sb_wait_lane0(bar, sbw67); }
        __syncthreads();
        pg8::Gemm g{WSP(bf16, WS_MIX), WSP(bf16, WS_WOUT), 1024, 1024, 1024, 0, nullptr, nullptr, 1 << 20}; pg8::StaticOrder S; S.init(MTOK, 1024, G, bx);
        EpiOut E{p.x, p.out, WSP(bf16, WS_H2B), WSP(float, WS_ROWSS)};
        pg8::gemm_phase<EpiOut, pg8::StaticOrder, true, true>(lds, g, S, E);
    }
    unsigned* const sbw78 = (unsigned*)(p.ws + WS_CTL) + 16384;
    if (IN(7) && IN(8)) sb_arrive(bar, sbw78);

    if (IN(8)) {
        { IDS(); p_ffw<1>(p, lds, gw, NGW, wave, lane); }
        if (IN(7)) { if (threadIdx.x == 0) sb_wait_lane0(bar, sbw78); }
        __syncthreads();
        pg8::Gemm g{WSP(bf16, WS_H2B), WSP(bf16, WS_WFF1), 1024, 1024, 1024, 0, nullptr, nullptr, 1 << 20}; pg8::StaticOrder S; S.init(MTOK, DFF, G, bx);
        EpiFF1 E{WSP(bf16, WS_HID), WSP(float, WS_ROWSS)};
        pg8::gemm_phase<EpiFF1, pg8::StaticOrder, true, true>(lds, g, S, E);
    } SEAM2(8, 5);

    if (IN(9)) {
        pg8::Gemm g{WSP(bf16, WS_HID), WSP(bf16, WS_WFF2), 4096, 4096, 4096, 0, nullptr, nullptr, 1 << 20}; pg8::StaticOrder S; S.init(MTOK, 1024, G, bx);
        EpiFF2 E{p.out, WSP(bf16, WS_H2B)};
        pg8::gemm_phase<EpiFF2, pg8::StaticOrder, true, true>(lds, g, S, E);
    }
#undef IN
#undef SEAM
}

extern "C" void kernel_launch(void* const* d_in, const int* in_sizes, int n_in, void* d_out, int out_size, void* d_ws, size_t ws_size, hipStream_t stream) {
    static int grid = 0;
    if (grid == 0) {
        if (n_in != 21 || in_sizes[0] != MTOK * DM || out_size != MTOK * DM || ws_size < WS_END) { fprintf(stderr, "kernel_launch: unexpected shapes (n_in %d, in0 %d, out %d, ws %zu); nothing launched\n", n_in, n_in > 0 ? in_sizes[0] : -1, out_size, ws_size); grid = -1; return; }
        int dev = 0, cus = 0, per_cu = 0;
        if (hipGetDevice(&dev) != hipSuccess || hipDeviceGetAttribute(&cus, hipDeviceAttributeMultiprocessorCount, dev) != hipSuccess) { grid = -1; return; }
        if (hipFuncSetAttribute((const void*)fwd_megakernel, hipFuncAttributeMaxDynamicSharedMemorySize, LDS_BYTES) != hipSuccess) { fprintf(stderr, "kernel_launch: hipFuncSetAttribute failed\n"); grid = -1; return; }
        if (hipOccupancyMaxActiveBlocksPerMultiprocessor(&per_cu, (const void*)fwd_megakernel, NTHR, LDS_BYTES) != hipSuccess || per_cu < 1) { fprintf(stderr, "kernel_launch: occupancy query reports %d workgroups per CU\n", per_cu); per_cu = 1; }
        (void)hipGetLastError();
        grid = cus;
    }
    if (grid < 0) return;
    if (hipMemsetAsync((char*)d_ws + WS_CTL, 0, CTL_ZERO_BYTES, stream) != hipSuccess) return;
    Args a{};
    const float** pp = (const float**)&a.p;
    for (int i = 0; i < 21; ++i) pp[i] = (const float*)d_in[i];
    a.p.out = (float*)d_out; a.p.ws = (unsigned char*)d_ws;
#ifndef MK_SUBFLAGS
#define MK_SUBFLAGS 0
#endif
#if defined(MK_DUP)
#ifndef MK_DUP_END
#define MK_DUP_END (MK_DUP + 1)
#endif
    const int cuts[4][2] = {{0, MK_DUP_END}, {MK_DUP, MK_DUP_END}, {MK_DUP_END, NPHASE}, {0, 0}};
    for (int li = 0; li < 3; ++li) { if (cuts[li][0] >= cuts[li][1]) continue; a.ph_lo = cuts[li][0]; a.ph_hi = cuts[li][1]; a.li = li; a.flags = (li == 1) ? (1 | MK_SUBFLAGS) : 0;
        hipLaunchKernelGGL(fwd_megakernel, dim3(grid), dim3(NTHR), LDS_BYTES, stream, a); }
#else
    a.ph_lo = 0; a.ph_hi = NPHASE; a.li = 0; a.flags = 0;
    hipLaunchKernelGGL(fwd_megakernel, dim3(grid), dim3(NTHR), LDS_BYTES, stream, a);
#endif
}
```

```cpp
#include <hip/hip_runtime.h>
#include <cstdio>
#include <cstdint>

namespace pg8 {
#define PG8_LAS __attribute__((address_space(3)))
typedef unsigned short bf16_t;
typedef short bf16x8 __attribute__((ext_vector_type(8)));
typedef float f32x4 __attribute__((ext_vector_type(4)));
typedef unsigned u32x4 __attribute__((ext_vector_type(4)));
typedef unsigned u32x2 __attribute__((ext_vector_type(2)));
constexpr int BM = 256, BK = 64, HALF = 128, HTB = HALF * BK * 2  , STAGE_BYTES = 8 * HTB, NXCD = 8, WGM = 8;

__host__ __device__ __forceinline__ int lds_byte(int r, int c) { const int st = (r >> 4) * 2 + (c >> 5), rr = r & 15, cc = c & 31, ob = rr * 64 + cc * 2; return st * 1024 + (ob ^ (((ob >> 9) & 1) << 5)); }
__host__ __device__ __forceinline__ void stage_rc(int b, int& R, int& C) { const int st = b / 1024, sb = b % 1024, swz = sb ^ (((sb >> 9) & 1) << 5); R = (st >> 1) * 16 + swz / 64; C = (st & 1) * 32 + (swz % 64) / 2; }
__host__ __device__ __forceinline__ int perm32(int rho) { const int n = rho >> 4, i = rho & 15; return 8 * (i >> 2) + 4 * n + (i & 3); }

struct Unit { int pm, pn; };
struct Gemm { const bf16_t* A; const bf16_t* Bt; int K, lda, ldb, a_pn_cols; const bf16_t* A1; const bf16_t* A2; int plane_tiles; };

struct StaticOrder {
    int nM, nN, nwg, G, c;
    __host__ __device__ void init(int M, int N, int G_, int c_) { nM = M / BM; nN = N / BM; nwg = nM * nN; G = G_; c = c_; }
    __host__ __device__ bool next(int i, Unit& u) const {
        const long L = (long)i * G + c; if (L >= nwg) return false;
        int wgid = (int)L; { const int q = nwg / NXCD, r = nwg % NXCD, xcd = wgid % NXCD, off = wgid / NXCD; wgid = (xcd < r ? xcd * (q + 1) : r * (q + 1) + (xcd - r) * q) + off; }
        const int nig = WGM * nN, gid = wgid / nig, fm = gid * WGM, gsz = (nM - fm) < WGM ? (nM - fm) : WGM;
        u.pm = fm + ((wgid % nig) % gsz); u.pn = (wgid % nig) / gsz; return true;
    }
};

typedef float f32x2_t __attribute__((ext_vector_type(2))); typedef __bf16 bf16x2_t __attribute__((ext_vector_type(2)));
__device__ __forceinline__ unsigned cvt_pk_safe(float lo, float hi) { f32x2_t v = {lo, hi}; bf16x2_t b = __builtin_convertvector(v, bf16x2_t); return __builtin_bit_cast(unsigned, b); }
__device__ __forceinline__ unsigned cvt_pk_bf16(float lo, float hi) { unsigned r; asm volatile("v_cvt_pk_bf16_f32 %0, %1, %2" : "=v"(r) : "v"(lo), "v"(hi)); return r; }

template <class Epi, class Sched, bool ALIGN_EPI = false, bool SP2 = false>
__device__ __forceinline__ void gemm_phase(PG8_LAS unsigned char* lds, const Gemm g, const Sched& S, const Epi& E) {
    const int tid = threadIdx.x, wid = __builtin_amdgcn_readfirstlane(tid >> 6), lane = tid & 63, wr = wid >> 2, wc = wid & 3, fr = lane & 15, fq = lane >> 4;
    const int K = g.K, nt = K / BK;
    unsigned voffA[2], voffB[2];
#pragma unroll
    for (int i = 0; i < 2; ++i) { int R, C; stage_rc(tid * 16 + i * 8192, R, C); const int Rb = Epi::PERM ? ((R & ~31) + perm32(R & 31)) : R;
        voffA[i] = (unsigned)(R * g.lda + C) * 2u; voffB[i] = (unsigned)(Rb * g.ldb + C) * 2u; }
    const size_t kstep = (size_t)(BK * 2);
    const size_t hstepA = (size_t)HALF * g.lda * 2, hstepB = (size_t)HALF * g.ldb * 2;
    const size_t tstepA = 2 * hstepA, tstepB = 2 * hstepB;
    const size_t pnA = (size_t)g.a_pn_cols * 2;
    const unsigned ldsw = (unsigned)wid * 1024u;
    const int aoff = lds_byte(wr * 64 + fr, fq * 8), boff = lds_byte(wc * 32 + fr, fq * 8);
#define PG8_SA(b, h) (((b) * 2 + (h)) * HTB)
#define PG8_SB(b, h) ((4 + (b) * 2 + (h)) * HTB)
#define PG8_STAGE(bufoff, gbase, voff) do { _Pragma("unroll") for (int _i = 0; _i < 2; ++_i) \
        __builtin_amdgcn_global_load_lds((const unsigned*)((const char*)(gbase) + (voff)[_i]), (PG8_LAS unsigned*)(lds + (bufoff) + ldsw + _i * 8192), 16, 0, 0); } while (0)
#define PG8_LDA(dst, b, h) do { _Pragma("unroll") for (int m = 0; m < 4; ++m) _Pragma("unroll") for (int k = 0; k < 2; ++k) dst[m][k] = *(const PG8_LAS bf16x8*)(lds + PG8_SA(b, h) + aoff + m * 2048 + k * 1024); } while (0)
#define PG8_LDB(dst, b, h) do { _Pragma("unroll") for (int n = 0; n < 2; ++n) _Pragma("unroll") for (int k = 0; k < 2; ++k) dst[n][k] = *(const PG8_LAS bf16x8*)(lds + PG8_SB(b, h) + boff + n * 2048 + k * 1024); } while (0)
#define PG8_MMA(ai, bj, At, Bt) do { __builtin_amdgcn_s_setprio(1); _Pragma("unroll") for (int m = 0; m < 4; ++m) _Pragma("unroll") for (int n = 0; n < 2; ++n) _Pragma("unroll") for (int k = 0; k < 2; ++k) \
        acc[ai][bj][m][n] = __builtin_amdgcn_mfma_f32_16x16x32_bf16(Bt[n][k], At[m][k], acc[ai][bj][m][n], 0, 0, 0); __builtin_amdgcn_s_setprio(0); } while (0)
#define PG8_WAIT_V(n) asm volatile("s_waitcnt vmcnt(" #n ")" ::: "memory")
#define PG8_WAIT_L(n) asm volatile("s_waitcnt lgkmcnt(" #n ")" ::: "memory")
#define PG8_BAR __builtin_amdgcn_s_barrier()
#define PG8_SCHED __builtin_amdgcn_sched_barrier(0)
    Unit cur, nxt; int ui = 0;
    if (!S.next(0, cur)) return;
    f32x4 acc[2][2][4][2];
#pragma unroll
    for (int a = 0; a < 2; ++a)
#pragma unroll
        for (int b = 0; b < 2; ++b)
#pragma unroll
            for (int m = 0; m < 4; ++m)
#pragma unroll
                for (int n = 0; n < 2; ++n) acc[a][b][m][n] = (f32x4){0.f, 0.f, 0.f, 0.f};
    bf16x8 At[4][2], B0[2][2], B1[2][2];
    const int pt = g.plane_tiles; const long long pj1 = (const char*)g.A1 - (const char*)g.A - (long long)pt * (long long)kstep, pj2 = (const char*)g.A2 - (const char*)g.A - 2ll * pt * (long long)kstep;
#define PG8_AT(base, t) ((base) + (size_t)(t) * kstep + (((t) >= pt) ? (((t) >= 2 * pt) ? pj2 : pj1) : 0ll))
    const char* cA = (const char*)g.A + (size_t)cur.pm * tstepA + (size_t)cur.pn * pnA; const char* cB = (const char*)g.Bt + (size_t)cur.pn * tstepB;
    if constexpr (SP2) {
        PG8_STAGE(PG8_SB(0, 0), cB, voffB); PG8_STAGE(PG8_SB(0, 1), cB + hstepB, voffB); PG8_STAGE(PG8_SA(0, 0), cA, voffA); PG8_STAGE(PG8_SA(0, 1), cA + hstepA, voffA);
        if (wr == 1) PG8_BAR;
        PG8_WAIT_V(2); PG8_BAR;
        PG8_STAGE(PG8_SB(1, 0), cB + kstep, voffB); PG8_STAGE(PG8_SA(1, 0), cA + kstep, voffA); PG8_STAGE(PG8_SB(1, 1), cB + hstepB + kstep, voffB);
        PG8_WAIT_V(6); PG8_BAR;
    } else {
        PG8_STAGE(PG8_SB(0, 0), cB, voffB); PG8_STAGE(PG8_SA(0, 0), cA, voffA); PG8_STAGE(PG8_SB(0, 1), cB + hstepB, voffB); PG8_STAGE(PG8_SA(0, 1), cA + hstepA, voffA);
        if (wr == 1) PG8_BAR;
        PG8_WAIT_V(4); PG8_BAR;
        PG8_STAGE(PG8_SB(1, 0), cB + kstep, voffB); PG8_STAGE(PG8_SA(1, 0), cA + kstep, voffA); PG8_STAGE(PG8_SB(1, 1), cB + hstepB + kstep, voffB);
        PG8_WAIT_V(6); PG8_BAR;
    }
    for (;;) {
        const bool has_next = S.next(ui + 1, nxt);
        const char* nA = has_next ? (const char*)g.A + (size_t)nxt.pm * tstepA + (size_t)nxt.pn * pnA : cA; const char* nB = has_next ? (const char*)g.Bt + (size_t)nxt.pn * tstepB : cB;
        for (int t = 0; t < nt; t += 2) {
            const bool last = (t == nt - 2);
            if constexpr (Epi::MID_T >= 0) { if (t == Epi::MID_T) E.mid(acc, cur, wr, wc, fr, fq); }
            const char* a1 = PG8_AT(cA, t + 1);
            const char* a2 = last ? nA : PG8_AT(cA, t + 2); const char* b2 = last ? nB : cB + (size_t)(t + 2) * kstep;
            const char* a3 = a2 + kstep; const char* b3 = b2 + kstep;
            if constexpr (SP2) {
            PG8_LDB(B0, 0, 0); PG8_LDB(B1, 0, 1); PG8_SCHED; PG8_LDA(At, 0, 0); PG8_STAGE(PG8_SA(1, 1), a1 + hstepA, voffA);
            PG8_WAIT_V(8); PG8_WAIT_L(0); PG8_BAR; PG8_MMA(0, 0, At, B0); PG8_MMA(0, 1, At, B1); PG8_BAR; PG8_SCHED;
            PG8_LDA(At, 0, 1); PG8_STAGE(PG8_SB(0, 0), b2, voffB); PG8_STAGE(PG8_SB(0, 1), b2 + hstepB, voffB); PG8_STAGE(PG8_SA(0, 0), a2, voffA);
            PG8_WAIT_V(8); PG8_WAIT_L(0); PG8_BAR; PG8_MMA(1, 0, At, B0); PG8_MMA(1, 1, At, B1); PG8_BAR; PG8_SCHED;
            PG8_LDB(B0, 1, 0); PG8_LDB(B1, 1, 1); PG8_SCHED; PG8_LDA(At, 1, 0); PG8_STAGE(PG8_SA(0, 1), a2 + hstepA, voffA);
            PG8_WAIT_V(8); PG8_WAIT_L(0); PG8_BAR; PG8_MMA(0, 0, At, B0); PG8_MMA(0, 1, At, B1); PG8_BAR; PG8_SCHED;
            PG8_LDA(At, 1, 1); PG8_STAGE(PG8_SB(1, 0), b3, voffB); PG8_STAGE(PG8_SB(1, 1), b3 + hstepB, voffB); PG8_STAGE(PG8_SA(1, 0), a3, voffA);
            PG8_WAIT_V(8); PG8_WAIT_L(0); PG8_BAR; PG8_MMA(1, 0, At, B0); PG8_MMA(1, 1, At, B1); PG8_BAR; PG8_SCHED;
            } else {
            PG8_LDB(B0, 0, 0); PG8_SCHED; PG8_LDA(At, 0, 0); PG8_STAGE(PG8_SA(1, 1), a1 + hstepA, voffA);
            PG8_WAIT_L(8); PG8_BAR; PG8_WAIT_L(0); PG8_MMA(0, 0, At, B0); PG8_BAR; PG8_SCHED;
            PG8_LDB(B1, 0, 1); PG8_STAGE(PG8_SB(0, 0), b2, voffB);
            PG8_BAR; PG8_WAIT_L(0); PG8_MMA(0, 1, At, B1); PG8_BAR;
            PG8_LDA(At, 0, 1); PG8_STAGE(PG8_SA(0, 0), a2, voffA);
            PG8_BAR; PG8_WAIT_L(0); PG8_MMA(1, 0, At, B0); PG8_BAR; PG8_SCHED;
            PG8_STAGE(PG8_SB(0, 1), b2 + hstepB, voffB);
            PG8_WAIT_V(6); PG8_BAR; PG8_MMA(1, 1, At, B1); PG8_BAR;
            PG8_LDB(B0, 1, 0); PG8_SCHED; PG8_LDA(At, 1, 0); PG8_STAGE(PG8_SA(0, 1), a2 + hstepA, voffA);
            PG8_WAIT_L(8); PG8_BAR; PG8_WAIT_L(0); PG8_MMA(0, 0, At, B0); PG8_BAR; PG8_SCHED;
            PG8_LDB(B1, 1, 1); PG8_STAGE(PG8_SB(1, 0), b3, voffB);
            PG8_BAR; PG8_WAIT_L(0); PG8_MMA(0, 1, At, B1); PG8_BAR;
            PG8_LDA(At, 1, 1); PG8_STAGE(PG8_SA(1, 0), a3, voffA);
            PG8_BAR; PG8_WAIT_L(0); PG8_MMA(1, 0, At, B0); PG8_BAR; PG8_SCHED;
            PG8_STAGE(PG8_SB(1, 1), b3 + hstepB, voffB);
            PG8_WAIT_V(6); PG8_BAR; PG8_MMA(1, 1, At, B1); PG8_BAR;
            }
        }
        if constexpr (ALIGN_EPI) { if (wr == 0) PG8_BAR; }
        { int t2 = threadIdx.x; asm volatile("" : "+v"(t2)); const int l2 = t2 & 63;
          E(acc, cur, wr, wc, l2 & 15, l2 >> 4); }
        if (!has_next) break;
#pragma unroll
        for (int a = 0; a < 2; ++a)
#pragma unroll
            for (int b = 0; b < 2; ++b)
#pragma unroll
                for (int m = 0; m < 4; ++m)
#pragma unroll
                    for (int n = 0; n < 2; ++n) acc[a][b][m][n] = (f32x4){0.f, 0.f, 0.f, 0.f};
        cur = nxt; cA = nA; cB = nB; ++ui;
        if constexpr (ALIGN_EPI) { if (wr == 1) PG8_BAR; }
    }
    PG8_WAIT_V(0);
    if constexpr (!ALIGN_EPI) { if (wr == 0) PG8_BAR; }
    PG8_BAR;
#undef PG8_AT
#undef PG8_SA
#undef PG8_SB
#undef PG8_STAGE
#undef PG8_LDA
#undef PG8_LDB
#undef PG8_MMA
#undef PG8_WAIT_V
#undef PG8_WAIT_L
#undef PG8_BAR
#undef PG8_SCHED
}
}

constexpr int NWAVES = 8, NTHR = 512;
constexpr int BATCH = 4, SEQ = 4096, DM = 1024, NMETA = 16, LSEQ = SEQ + NMETA;
constexpr int RV = BATCH * LSEQ;
constexpr int RP = 16640;
constexpr int MTOK = BATCH * SEQ;
constexpr int NIN = 5888;
constexpr int MH = 4, MDV = 256, MDK = 128, NAH = 8, NADH = 64, NAI = 512, DFF = 4096;
constexpr int NCHUNK = 65;
constexpr float EPS = 1e-6f;

constexpr size_t MiB = 1u << 20, QMiB = 1u << 18;
constexpr size_t WS_CTL = 0, CTL_ZERO_BYTES = 128 * 1024;
constexpr size_t WS_WIN = 3 * MiB;
constexpr size_t WS_WQK = 58 * QMiB;
constexpr size_t WS_WA = 15 * MiB;
constexpr size_t WS_WB = 17 * MiB;
constexpr size_t WS_WOUT = 18 * MiB;
constexpr size_t WS_RA = 20 * MiB;
constexpr size_t WS_VR = WS_RA, WS_WFF1 = WS_RA, WS_WFF2 = WS_RA + 8 * MiB;
constexpr size_t WS_SFRAG = 3 * MiB;
constexpr size_t WS_RB = 145 * QMiB;
constexpr size_t WS_XM = WS_RB, WS_H2B = WS_RB;
constexpr size_t WS_RC = 275 * QMiB;
constexpr size_t WS_SO = WS_RC, WS_MIX = WS_RC;
constexpr size_t WS_QN = 405 * QMiB;
constexpr size_t WS_KN = 470 * QMiB;
constexpr size_t WS_YB = 535 * QMiB;
constexpr size_t WS_FAC = WS_YB;
constexpr size_t WS_YA = 730 * QMiB;
constexpr size_t WS_RG = 150 * MiB;
constexpr size_t WS_XN = WS_RG, WS_XC = WS_RG, WS_HF = WS_RG;
constexpr size_t WS_QKM = 730 * QMiB;
constexpr size_t WS_HB = 215 * MiB;
constexpr size_t WS_GATES = 247 * MiB;
constexpr size_t WS_SCAL = 994 * QMiB;
constexpr size_t WS_ROWSS = 1002 * QMiB;
constexpr size_t WS_HID = WS_QN;
constexpr size_t WS_END = 256 * MiB;
constexpr size_t SCAL_ARR = (size_t)32 * NCHUNK * 64;
static_assert(WS_SFRAG + (size_t)32 * 64 * 6 * 1024 <= WS_WA && WS_GATES + (size_t)RP * 16 * 4 <= WS_SCAL && WS_SCAL + 3 * SCAL_ARR * 4 <= WS_ROWSS && WS_ROWSS + (size_t)MTOK * 16 * 4 <= WS_END, "small buffers");
static_assert(WS_YB + (size_t)MTOK * 512 * 2 <= WS_RG && WS_HID + (size_t)MTOK * DFF * 2 <= WS_GATES && WS_H2B + (size_t)MTOK * DM * 2 <= WS_RC, "ws map");
constexpr int CW_BAR = 4096;

constexpr int RING_BYTES = 131072;
constexpr int LDSCTL_OFF = 146944, MISC_OFF = LDSCTL_OFF + 320;
constexpr int LDS_BYTES = 147456;

#define GAS __attribute__((address_space(1)))
#define LAS __attribute__((address_space(3)))
typedef unsigned short bf16;
typedef unsigned v4u __attribute__((ext_vector_type(4)));
typedef unsigned v2u __attribute__((ext_vector_type(2)));
typedef float f32x4 __attribute__((ext_vector_type(4)));
typedef short bf16x8 __attribute__((ext_vector_type(8)));
typedef short s16x4 __attribute__((ext_vector_type(4)));
typedef GAS unsigned gu32;
#define RLX_AGENT __ATOMIC_RELAXED, __HIP_MEMORY_SCOPE_AGENT
#define LDS_WAIT() asm volatile("s_waitcnt lgkmcnt(0)" ::: "memory")
__device__ __forceinline__ unsigned f2bf(float f) { unsigned u = __builtin_bit_cast(unsigned, f); return (u + 0x7fffu + ((u >> 16) & 1u)) >> 16; }
__device__ __forceinline__ unsigned pk2(float lo, float hi) { return f2bf(lo) | (f2bf(hi) << 16); }
__device__ __forceinline__ float bflo(unsigned u) { return __builtin_bit_cast(float, u << 16); }
__device__ __forceinline__ float bfhi(unsigned u) { return __builtin_bit_cast(float, u & 0xffff0000u); }
__device__ __forceinline__ float bf1(unsigned short u) { return __builtin_bit_cast(float, (unsigned)u << 16); }
__device__ __forceinline__ float sigmoidf_(float x) { return __builtin_amdgcn_rcpf(1.0f + __expf(-x)); }

#define XB_TMO      128
#define XB_XCNT(j)  (256  + 64 * (j))
#define XB_XSUB(j)  (1280 + 64 * (j))
#define XB_XGEN(j)  (2304 + 64 * (j))
#define XB_TOP      3328
#define XB_TOPGEN   3392
#define XCD_BAR_WORDS 3456
#define XB_SPIN_CAP (1u << 22)

__device__ __forceinline__ unsigned xb_ld(unsigned* p)              { return __hip_atomic_load(p, __ATOMIC_RELAXED, __HIP_MEMORY_SCOPE_AGENT); }
__device__ __forceinline__ unsigned xb_add(unsigned* p, unsigned v) { return __hip_atomic_fetch_add(p, v, __ATOMIC_RELAXED, __HIP_MEMORY_SCOPE_AGENT); }
__device__ __forceinline__ unsigned xb_xcc_id() { return (unsigned)__builtin_amdgcn_s_getreg((3 << 11) | 20) & 0xFu; }
#define XB_SPIN(cond, bar) do { unsigned _sp = 0; while (cond) { __builtin_amdgcn_s_sleep(1); \
    if ((++_sp & 255u) == 0u) { if (xb_ld(&(bar)[XB_TMO])) break; if (_sp > XB_SPIN_CAP) { atomicAdd(&(bar)[XB_TMO], 1u); break; } } } } while (0)

struct XcdBarrier { unsigned* bar; unsigned x; volatile LAS unsigned* st; };

__device__ __forceinline__ XcdBarrier xcd_barrier_post(unsigned* bar, volatile LAS unsigned* st) {
    XcdBarrier b; b.bar = bar; b.x = xb_xcc_id(); b.st = st;
    if (threadIdx.x == 0) (void)xb_add(&bar[XB_XCNT(b.x)], 1u);
    return b;
}
__device__ __forceinline__ void xcd_barrier_complete(unsigned* bar, unsigned x, unsigned& nloc, unsigned& nx) {
    const unsigned G = gridDim.x * gridDim.y * gridDim.z;
    unsigned sum, cnt, mine, sp = 0u;
    for (;;) {
        sum = 0u; cnt = 0u; mine = 0u;
#pragma unroll
        for (unsigned j = 0; j < 16; ++j) { const unsigned c = xb_ld(&bar[XB_XCNT(j)]); sum += c; cnt += (c > 0u) ? 1u : 0u; mine = (j == x) ? c : mine; }
        if (sum == G) break;
        __builtin_amdgcn_s_sleep(1);
        if ((++sp & 255u) == 0u) { if (xb_ld(&bar[XB_TMO])) break; if (sp > XB_SPIN_CAP) { atomicAdd(&bar[XB_TMO], 1u); break; } }
    }
    nloc = mine > 0u ? mine : 1u; nx = cnt > 0u ? cnt : 1u;
}
__device__ __forceinline__ void xcd_barrier(const XcdBarrier& b) {
    asm volatile("s_waitcnt vmcnt(0)" ::: "memory");
    __syncthreads();
    if (threadIdx.x == 0) {
        unsigned* bar = b.bar;
        __builtin_amdgcn_s_waitcnt(0);
        unsigned nloc = b.st[0], nx = b.st[1];
        if (nloc == 0u) { xcd_barrier_complete(bar, b.x, nloc, nx); b.st[0] = nloc; b.st[1] = nx; }
        const unsigned old = xb_add(&bar[XB_XSUB(b.x)], 1u);
        const unsigned gen = old / nloc;
        if (old + 1u == (gen + 1u) * nloc) {
            __builtin_amdgcn_fence(__ATOMIC_RELEASE, "agent");
            asm volatile("s_waitcnt vmcnt(0)" ::: "memory");
            const unsigned og = xb_add(&bar[XB_TOP], 1u);
            const unsigned tg = og / nx;
            if (og + 1u == (tg + 1u) * nx) xb_add(&bar[XB_TOPGEN], 1u);
            else XB_SPIN(xb_ld(&bar[XB_TOPGEN]) == tg, bar);
            __builtin_amdgcn_fence(__ATOMIC_ACQUIRE, "agent");
            xb_add(&bar[XB_XGEN(b.x)], 1u);
            asm volatile("s_waitcnt vmcnt(0)" ::: "memory");
        } else {
            XB_SPIN(xb_ld(&bar[XB_XGEN(b.x)]) == gen, bar);
            __builtin_amdgcn_fence(__ATOMIC_ACQUIRE, "agent");
            asm volatile("s_waitcnt vmcnt(0)" ::: "memory");
        }
    }
    __syncthreads();
}

__device__ __forceinline__ void sb_arrive(const XcdBarrier& b, unsigned* w) {
    asm volatile("s_waitcnt vmcnt(0)" ::: "memory");
    __syncthreads();
    if (threadIdx.x == 0) {
        __builtin_amdgcn_s_waitcnt(0);
        unsigned nloc = b.st[0], nx = b.st[1];
        if (nloc == 0u) { xcd_barrier_complete(b.bar, b.x, nloc, nx); b.st[0] = nloc; b.st[1] = nx; }
        const unsigned old = xb_add(&w[64 * b.x], 1u);
        if (old + 1u == nloc) {
            __builtin_amdgcn_fence(__ATOMIC_RELEASE, "agent");
            asm volatile("s_waitcnt vmcnt(0)" ::: "memory");
            xb_add(&w[1024], 1u);
        }
    }
}
__device__ __forceinline__ void sb_wait_lane0(const XcdBarrier& b, unsigned* w) {
    const unsigned nx = b.st[1];
    XB_SPIN(xb_ld(&w[1024]) < nx, b.bar);
    __builtin_amdgcn_fence(__ATOMIC_ACQUIRE, "agent");
    asm volatile("s_waitcnt vmcnt(0)" ::: "memory");
}

__device__ __forceinline__ float wave_sum(float v) {
#pragma unroll
    for (int o = 1; o < 64; o <<= 1) v += __shfl_xor(v, o);
    return v;
}

struct Ptrs {
    const float *x, *meta, *norm1_g, *w_in, *conv_w, *conv_b, *wq, *wk, *gate_b, *mnorm_g, *mskip, *qn_g, *kn_g, *rpb, *mbias, *w_a, *w_b, *w_out, *norm2_g, *w_ff1, *w_ff2;
    float* out; unsigned char* ws;
};
#define WSP(T, off) ((T*)(p.ws + (off)))

constexpr int SCR_STRIDE = 18368;
__device__ __forceinline__ void p0_tr64(const float* W, int ldw, int srccol0, int nvalid, bf16* WT, int pitch, int drow0, int k0, int kdst0, const float* kscale, float scale, LAS float* scr, int lane, int hi_skip = 0) {
    (void)scr;
    const int n4 = lane & 15, kq = lane >> 4; if (n4 >= 8) srccol0 += hi_skip;
    f32x4 v[2][8];
#pragma unroll
    for (int hk = 0; hk < 2; ++hk)
#pragma unroll
        for (int j = 0; j < 8; ++j) { v[hk][j] = (f32x4){0.f, 0.f, 0.f, 0.f}; if (4 * n4 < nvalid) v[hk][j] = *(const GAS f32x4*)(W + (size_t)(k0 + 32 * hk + 8 * kq + j) * ldw + srccol0 + 4 * n4); }
#pragma unroll
    for (int hk = 0; hk < 2; ++hk) { float s[8];
#pragma unroll
        for (int j = 0; j < 8; ++j) { s[j] = scale; if (kscale) s[j] *= kscale[k0 + 32 * hk + 8 * kq + j]; }
#pragma unroll
        for (int e = 0; e < 4; ++e) { v4u o; o.x = pk2(v[hk][0][e] * s[0], v[hk][1][e] * s[1]); o.y = pk2(v[hk][2][e] * s[2], v[hk][3][e] * s[3]); o.z = pk2(v[hk][4][e] * s[4], v[hk][5][e] * s[5]); o.w = pk2(v[hk][6][e] * s[6], v[hk][7][e] * s[7]);
            *(GAS v4u*)(WT + (size_t)(drow0 + 4 * n4 + e) * pitch + kdst0 + k0 + 32 * hk + 8 * kq) = o; } }
}
__device__ __forceinline__ void p0_plain(const float* W, int K, int N, bf16* WT, int pitch, int kdst0, const float* kscale, float scale, LAS float* scr, int item, int lane) {
    const int nblk = N / 64, kb = item / nblk, nb = item % nblk;
    p0_tr64(W, N, 64 * nb, 64, WT, pitch, 64 * nb, 64 * kb, kdst0, kscale, scale, scr, lane);
}
template <int PART>
__device__ __forceinline__ void p0_prologue(const Ptrs& p, LAS unsigned char* lds, int gw, int NGW, int wave, int lane) {
    LAS float* scr = (LAS float*)(lds + wave * SCR_STRIDE);
    constexpr int I_IN = 16 * (NIN / 64), I_QK = 4 * 2 * 4 * 2, I_A = 16 * 16, I_B = 8 * 16, I_O = 16 * 16;
    constexpr int NITEMS = I_IN + I_QK + I_A + I_B + I_O;
    for (int it = (PART == 0 ? gw : I_IN + I_QK + gw); it < (PART == 0 ? I_IN + I_QK : NITEMS); it += NGW) {
        int r = it;
        if (r < I_IN) { const int nblk = NIN / 64, kb = r / nblk, nb = r % nblk, n0 = 64 * nb;
            int src, nv;
            int hs = 0;
            if (n0 < 2048) { src = n0; nv = 64; }
            else if (n0 < 3072) { const int t = (n0 - 2048) >> 8, w = (n0 - 2048) & 255, bj = w >> 7, hl = (w & 127) >> 5;
                src = (t < 2 ? 2064 : 2576) + (4 * (t & 1) + hl) * 64 + 32 * bj; nv = 64; hs = 32; }
            else if (n0 < 3584) { src = n0 + 16; nv = 64; }
            else if (n0 < 5632) { const int k = (n0 - 3584) >> 8, w = (n0 - 3584) & 255; src = (w < 128 ? 3600 : 4624 - 128) + 128 * k + w; nv = 64; }
            else if (n0 == 5632) { src = 2048; nv = 16; } else { src = 0; nv = 0; }
            p0_tr64(p.w_in, 5648, src, nv, WSP(bf16, WS_WIN), 1024, n0, 64 * kb, 0, nullptr, 1.f, scr, lane, hs); continue; } r -= I_IN;
        if (r < I_QK) { const int h = r >> 4, qk = (r >> 3) & 1, sub = r & 7, kb = sub >> 1, nb = sub & 1;
            const float* W = (qk ? p.wk : p.wq) + (size_t)h * 256 * 128;
            p0_tr64(W, 128, 64 * nb, 64, WSP(bf16, WS_WQK) + (size_t)h * 256 * 256, 256, qk * 128 + 64 * nb, 64 * kb, 0, nullptr, qk ? 0.08838834764831845f : 1.f, scr, lane); continue; } r -= I_QK;
        if (r < I_A) { p0_plain(p.w_a, 1024, 1024, WSP(bf16, WS_WA), 1536, 0, nullptr, 1.f, scr, r, lane); continue; } r -= I_A;
        if (r < I_B) { p0_plain(p.w_b, 512, 1024, WSP(bf16, WS_WA), 1536, 1024, nullptr, 1.f, scr, r, lane); continue; } r -= I_B;
        p0_plain(p.w_out, 1024, 1024, WSP(bf16, WS_WOUT), 1024, 0, nullptr, 1.f, scr, r, lane);
    }
    if constexpr (PART == 1) return;
    bf16* XN = WSP(bf16, WS_XN);
    const GAS f32x4* g1 = (const GAS f32x4*)p.norm1_g + lane;
    for (int row0 = 2 * (NGW - 1 - gw); row0 < RP; row0 += 2 * NGW) {
        f32x4 v[2][4]; float s[2] = {0.f, 0.f};
#pragma unroll
        for (int q = 0; q < 2; ++q) { const int row = row0 + q;
            if (row < RV) { const int b = row / LSEQ, l = row - b * LSEQ;
                const float* src = (l < NMETA) ? p.meta + (size_t)l * DM : p.x + ((size_t)b * SEQ + (l - NMETA)) * DM;
                const GAS f32x4* xr = (const GAS f32x4*)src + lane;
#pragma unroll
                for (int j = 0; j < 4; ++j) v[q][j] = xr[64 * j]; }
            else {
#pragma unroll
                for (int j = 0; j < 4; ++j) v[q][j] = (f32x4){0.f, 0.f, 0.f, 0.f}; } }
#pragma unroll
        for (int q = 0; q < 2; ++q)
#pragma unroll
            for (int j = 0; j < 4; ++j) s[q] += (v[q][j].x * v[q][j].x + v[q][j].y * v[q][j].y) + (v[q][j].z * v[q][j].z + v[q][j].w * v[q][j].w);
#pragma unroll
        for (int q = 0; q < 2; ++q) { const float rs = 1.0f / sqrtf(wave_sum(s[q]) * (1.f / DM) + EPS);
            GAS unsigned long long* o8 = (GAS unsigned long long*)(XN + (size_t)(row0 + q) * DM) + lane;
#pragma unroll
            for (int j = 0; j < 4; ++j) { const f32x4 g = g1[64 * j]; o8[64 * j] = (unsigned long long)pk2(v[q][j].x * rs * g.x, v[q][j].y * rs * g.y) | ((unsigned long long)pk2(v[q][j].z * rs * g.z, v[q][j].w * rs * g.w) << 32); } }
    }
}
template <int PART>
__device__ __forceinline__ void p_ffw(const Ptrs& p, LAS unsigned char* lds, int gw, int NGW, int wave, int lane) {
    constexpr int I_1 = 16 * 64, I_2 = 64 * 16;
    for (int it = gw; it < (PART == 0 ? I_1 : I_2); it += NGW) {
        if constexpr (PART == 0) p0_plain(p.w_ff1, 1024, 4096, WSP(bf16, WS_WFF1), 1024, 0, p.norm2_g, 1.f, nullptr, it, lane);
        else p0_plain(p.w_ff2, 4096, 1024, WSP(bf16, WS_WFF2), 4096, 0, nullptr, 1.f, nullptr, it, lane);
    }
}

struct EpiIn {
    static constexpr bool PERM = true; static constexpr int MID_T = -1;
    unsigned char* ws; float* out; const float* qng; const float* kng;
    __device__ __forceinline__ void operator()(const pg8::f32x4 (&acc)[2][2][4][2], const pg8::Unit& u, int wr, int wc, int fr, int fq) const {
        using namespace pg8;
        const int row0 = u.pm * BM + wr * 64 + fr, pn = u.pn;
        const int cl = wc * 32 + 8 * fq;
        if (pn == 22) {
            if (wc == 0 && fq < 2) { float* G = (float*)(ws + WS_GATES);
#pragma unroll
                for (int ai = 0; ai < 2; ++ai)
#pragma unroll
                    for (int m = 0; m < 4; ++m) { float* rp = G + (size_t)(row0 + ai * HALF + m * 16) * 16 + 8 * fq;
                        *(f32x4*)rp = acc[ai][0][m][0]; *(f32x4*)(rp + 4) = acc[ai][0][m][1]; } }
            return; }
        if (pn >= 8 && pn < 12) {
            const bool isk = pn >= 10; const int head = 4 * (pn & 1) + wc; bf16_t* base = (bf16_t*)(ws + (isk ? WS_KN : WS_QN)) + head * 64 + 8 * fq;
            const float* gp = (isk ? kng : qng) + 8 * fq; float gn[2][8];
#pragma unroll
            for (int bj = 0; bj < 2; ++bj)
#pragma unroll
                for (int e = 0; e < 8; ++e) gn[bj][e] = gp[32 * bj + e] * (isk ? 1.0f : 0.125f * 1.4426950408889634f);
#pragma unroll
            for (int ai = 0; ai < 2; ++ai)
#pragma unroll
                for (int m = 0; m < 4; ++m) { const int row = row0 + ai * HALF + m * 16; float ss = 0.f;
#pragma unroll
                    for (int bj = 0; bj < 2; ++bj)
#pragma unroll
                        for (int n = 0; n < 2; ++n) { const f32x4 v = acc[ai][bj][m][n]; ss += (v[0] * v[0] + v[1] * v[1]) + (v[2] * v[2] + v[3] * v[3]); }
                    ss += __shfl_xor(ss, 16); ss += __shfl_xor(ss, 32);
                    const float rs = 1.0f / sqrtf(ss * (1.f / 64.f) + EPS);
#pragma unroll
                    for (int bj = 0; bj < 2; ++bj) { const f32x4 v0 = acc[ai][bj][m][0] * rs, v1 = acc[ai][bj][m][1] * rs;
                        u32x4 w; w.x = cvt_pk_bf16(v0[0] * gn[bj][0], v0[1] * gn[bj][1]); w.y = cvt_pk_bf16(v0[2] * gn[bj][2], v0[3] * gn[bj][3]); w.z = cvt_pk_bf16(v1[0] * gn[bj][4], v1[1] * gn[bj][5]); w.w = cvt_pk_bf16(v1[2] * gn[bj][6], v1[3] * gn[bj][7]);
                        *(u32x4*)(base + (size_t)row * 512 + 32 * bj) = w; } }
            return; }
        bf16_t* base; int ldc, col; bool sig = false, tok = false;
        if (pn < 4) { base = (bf16_t*)(ws + WS_XM); ldc = 1024; col = pn * 256; }
        else if (pn < 8) { base = (bf16_t*)(ws + WS_SO); ldc = 1024; col = (pn - 4) * 256; sig = true; }
        else if (pn < 14) { base = (bf16_t*)(ws + WS_VR); ldc = 512; col = (pn - 12) * 256; }
        else {
            bf16_t* GR = (bf16_t*)out; bf16_t* GB = (bf16_t*)out + (size_t)MTOK * 1024; const int gcol = (pn - 14) * 128 + cl;
#pragma unroll
            for (int ai = 0; ai < 2; ++ai)
#pragma unroll
                for (int m = 0; m < 4; ++m) {
                    int row = row0 + ai * HALF + m * 16; const int b = row / LSEQ, l = row - b * LSEQ; if (row >= RV || l < NMETA) continue; row = b * SEQ + l - NMETA;
                    float gr[8], gb[8];
#pragma unroll
                    for (int n = 0; n < 2; ++n)
#pragma unroll
                        for (int e = 0; e < 4; ++e) { const float ea = __expf(-acc[ai][0][m][n][e]), eb2 = __expf(-acc[ai][1][m][n][e]); const float sb = __builtin_amdgcn_rcpf(1.0f + eb2);
                            gb[4 * n + e] = sb; gr[4 * n + e] = (1.0f + eb2) * __builtin_amdgcn_rcpf(1.0f + ea); }
                    u32x4 w; w.x = cvt_pk_bf16(gr[0], gr[1]); w.y = cvt_pk_bf16(gr[2], gr[3]); w.z = cvt_pk_bf16(gr[4], gr[5]); w.w = cvt_pk_bf16(gr[6], gr[7]);
                    *(u32x4*)(GR + (size_t)row * 1024 + gcol) = w;
                    w.x = cvt_pk_bf16(gb[0], gb[1]); w.y = cvt_pk_bf16(gb[2], gb[3]); w.z = cvt_pk_bf16(gb[4], gb[5]); w.w = cvt_pk_bf16(gb[6], gb[7]);
                    *(u32x4*)(GB + (size_t)row * 1024 + gcol) = w; }
            return; }
#pragma unroll
        for (int ai = 0; ai < 2; ++ai)
#pragma unroll
            for (int m = 0; m < 4; ++m) {
                int row = row0 + ai * HALF + m * 16; bool ok = true;
                if (tok) { const int b = row / LSEQ, l = row - b * LSEQ; ok = (row < RV) && (l >= NMETA); row = b * SEQ + l - NMETA; }
                if (!ok) continue;
                bf16_t* rowp = base + (size_t)row * ldc + col + cl;
#pragma unroll
                for (int bj = 0; bj < 2; ++bj) { f32x4 v0 = acc[ai][bj][m][0], v1 = acc[ai][bj][m][1];
                    if (sig) {
#pragma unroll
                        for (int e = 0; e < 4; ++e) { v0[e] = sigmoidf_(v0[e]); v1[e] = sigmoidf_(v1[e]); } }
                    u32x4 w; w.x = cvt_pk_bf16(v0[0], v0[1]); w.y = cvt_pk_bf16(v0[2], v0[3]); w.z = cvt_pk_bf16(v1[0], v1[1]); w.w = cvt_pk_bf16(v1[2], v1[3]);
                    *(u32x4*)(rowp + bj * HALF) = w; } }
    }
};

__device__ __forceinline__ void conv_silu16(const bf16* XM, int b, int l, int lane, const float (&cw)[3][16], const float (&cb)[16], float (&o)[16]) {
    const bf16* r1 = XM + ((size_t)b * LSEQ + l) * DM + 16 * lane;
    v4u a0[2] = {{0, 0, 0, 0}, {0, 0, 0, 0}}, a1[2], a2[2] = {{0, 0, 0, 0}, {0, 0, 0, 0}};
    a1[0] = *(const GAS v4u*)r1; a1[1] = *(const GAS v4u*)(r1 + 8);
    if (l > 0) { a0[0] = *(const GAS v4u*)(r1 - DM); a0[1] = *(const GAS v4u*)(r1 - DM + 8); }
    if (l < LSEQ - 1) { a2[0] = *(const GAS v4u*)(r1 + DM); a2[1] = *(const GAS v4u*)(r1 + DM + 8); }
#pragma unroll
    for (int q = 0; q < 2; ++q)
#pragma unroll
        for (int e = 0; e < 4; ++e) {
            const int c = q * 8 + e * 2;
            const float y0 = cb[c] + cw[0][c] * bflo(a0[q][e]) + cw[1][c] * bflo(a1[q][e]) + cw[2][c] * bflo(a2[q][e]);
            const float y1 = cb[c + 1] + cw[0][c + 1] * bfhi(a0[q][e]) + cw[1][c + 1] * bfhi(a1[q][e]) + cw[2][c + 1] * bfhi(a2[q][e]);
            o[c] = y0 * sigmoidf_(y0); o[c + 1] = y1 * sigmoidf_(y1); }
}
__device__ __forceinline__ void load_conv_w(const Ptrs& p, int lane, float (&cw)[3][16], float (&cb)[16]) {
#pragma unroll
    for (int j = 0; j < 3; ++j)
#pragma unroll
        for (int q = 0; q < 4; ++q) { const f32x4 v = *(const GAS f32x4*)(p.conv_w + (size_t)j * DM + 16 * lane + 4 * q); cw[j][4 * q] = v.x; cw[j][4 * q + 1] = v.y; cw[j][4 * q + 2] = v.z; cw[j][4 * q + 3] = v.w; }
#pragma unroll
    for (int q = 0; q < 4; ++q) { const f32x4 v = *(const GAS f32x4*)(p.conv_b + 16 * lane + 4 * q); cb[4 * q] = v.x; cb[4 * q + 1] = v.y; cb[4 * q + 2] = v.z; cb[4 * q + 3] = v.w; }
}
__device__ __forceinline__ v4u conv_silu8_raw(const v4u a0, const v4u a1, const v4u a2, const float (&cw)[3][8], const float (&cb)[8]) {
    v4u o;
#pragma unroll
    for (int e = 0; e < 4; ++e) { const int c = 2 * e;
        const float y0 = cb[c] + cw[0][c] * bflo(a0[e]) + cw[1][c] * bflo(a1[e]) + cw[2][c] * bflo(a2[e]);
        const float y1 = cb[c + 1] + cw[0][c + 1] * bfhi(a0[e]) + cw[1][c + 1] * bfhi(a1[e]) + cw[2][c + 1] * bfhi(a2[e]);
        o[e] = pk2(y0 * sigmoidf_(y0), y1 * sigmoidf_(y1)); }
    return o;
}
__device__ __forceinline__ v4u conv_silu8(const bf16* XM, int b, int l, int col0, const float (&cw)[3][8], const float (&cb)[8]) {
    const bf16* r1 = XM + ((size_t)b * LSEQ + l) * DM + col0;
    v4u a0 = {0, 0, 0, 0}, a2 = {0, 0, 0, 0}; const v4u a1 = *(const GAS v4u*)r1;
    if (l > 0) a0 = *(const GAS v4u*)(r1 - DM);
    if (l < LSEQ - 1) a2 = *(const GAS v4u*)(r1 + DM);
    return conv_silu8_raw(a0, a1, a2, cw, cb);
}
__device__ __forceinline__ void load_conv_w8(const Ptrs& p, int col0, float (&cw)[3][8], float (&cb)[8]) {
#pragma unroll
    for (int j = 0; j < 3; ++j)
#pragma unroll
        for (int q = 0; q < 2; ++q) { const f32x4 v = *(const GAS f32x4*)(p.conv_w + (size_t)j * DM + col0 + 4 * q); cw[j][4 * q] = v.x; cw[j][4 * q + 1] = v.y; cw[j][4 * q + 2] = v.z; cw[j][4 * q + 3] = v.w; }
#pragma unroll
    for (int q = 0; q < 2; ++q) { const f32x4 v = *(const GAS f32x4*)(p.conv_b + col0 + 4 * q); cb[4 * q] = v.x; cb[4 * q + 1] = v.y; cb[4 * q + 2] = v.z; cb[4 * q + 3] = v.w; }
}
__device__ __forceinline__ void gate_scalars(const Ptrs& p, int gw, int NGW, int lane) {
    const float* GT = WSP(float, WS_GATES); float* SB = WSP(float, WS_SCAL); float* SG = SB + SCAL_ARR; float* SPM = SG + SCAL_ARR;
    for (int it = gw; it < 32 * NCHUNK; it += NGW) {
        const int seq = it / NCHUNK, c = it - seq * NCHUNK, dir = seq & 1, h = (seq >> 1) & 3, b = seq >> 3;
        const int l = dir ? (LSEQ - 1 - 64 * c - lane) : (64 * c + lane - 48);
        float li = -1e9f, lf = 0.f;
        if (l >= 0) { const float* gr = GT + ((size_t)b * LSEQ + l) * 16 + dir * 8 + h;
            li = gr[0] + p.gate_b[(dir * 2) * 4 + h];
            const float f = gr[4] + p.gate_b[(dir * 2 + 1) * 4 + h];
            lf = -(fmaxf(-f, 0.f) + log1pf(expf(-fabsf(f)))); }
        float bs = lf;
#pragma unroll
        for (int o = 1; o < 64; o <<= 1) { const float t = __shfl_up(bs, o); if (lane >= o) bs += t; }
        const float gg = li - bs; float pm = gg;
#pragma unroll
        for (int o = 1; o < 64; o <<= 1) { const float t = __shfl_up(pm, o); if (lane >= o) pm = fmaxf(pm, t); }
        const size_t idx = (size_t)it * 64 + lane; SB[idx] = bs; SG[idx] = gg; SPM[idx] = pm;
    }
}
__device__ __forceinline__ void p3_head(const Ptrs& p, LAS unsigned char* lds, int pm, int h, int vcu, int gw, int NGW, int wave, int lane) {
    const bf16* XM = WSP(bf16, WS_XM); bf16* XC = WSP(bf16, WS_XC);
    const int col0 = h * 256 + 8 * (lane & 31);
    const bool extra = vcu < 16;
    const int rt = vcu & 3, hh = (vcu >> 2) & 3, c16 = lane & 15, g = lane >> 4;
    bf16x8 bfr[2][8];
    { float cw[3][8], cb[8]; load_conv_w8(p, col0, cw, cb);
      const int rbase = 256 * pm + 32 * wave + 16 * (lane >> 5);
      v4u rw[18];
#pragma unroll
      for (int i = 0; i < 18; ++i) { const int row = rbase + i - 1, b = (row < 0 ? 0 : row) / LSEQ, l = row - b * LSEQ; rw[i] = (v4u){0, 0, 0, 0};
          if (row >= 0 && row < RV) rw[i] = *(const GAS v4u*)(XM + (size_t)row * DM + col0); (void)l; }
      v4u xa0 = {0, 0, 0, 0}, xa1 = {0, 0, 0, 0}, xa2 = {0, 0, 0, 0};
      const int xrow = MTOK + 16 * rt + 2 * wave + (lane >> 5), xb = xrow / LSEQ, xl = xrow - xb * LSEQ, colx = hh * 256 + 8 * (lane & 31);
      if (extra) { const bf16* r1 = XM + (size_t)xrow * DM + colx; xa1 = *(const GAS v4u*)r1; if (xl > 0) xa0 = *(const GAS v4u*)(r1 - DM); if (xl < LSEQ - 1) xa2 = *(const GAS v4u*)(r1 + DM);
#pragma unroll
          for (int t2 = 0; t2 < 2; ++t2) { const bf16* bp = WSP(bf16, WS_WQK) + (size_t)(hh * 256 + 16 * (2 * wave + t2) + c16) * 256 + 8 * g;
#pragma unroll
              for (int ks = 0; ks < 8; ++ks) bfr[t2][ks] = *(const GAS bf16x8*)(bp + 32 * ks); } }
#pragma unroll
      for (int i = 0; i < 16; ++i) { const int row = rbase + i, b = row / LSEQ, l = row - b * LSEQ;
          const v4u a0 = (l > 0) ? rw[i] : (v4u){0, 0, 0, 0}, a1 = rw[i + 1], a2 = (l < LSEQ - 1) ? rw[i + 2] : (v4u){0, 0, 0, 0};
          v4u o;
#pragma unroll
          for (int e = 0; e < 4; ++e) { const int cc = 2 * e;
              const float y0 = cb[cc] + cw[0][cc] * bflo(a0[e]) + cw[1][cc] * bflo(a1[e]) + cw[2][cc] * bflo(a2[e]);
              const float y1 = cb[cc + 1] + cw[0][cc + 1] * bfhi(a0[e]) + cw[1][cc + 1] * bfhi(a1[e]) + cw[2][cc + 1] * bfhi(a2[e]);
              o[e] = pk2(y0 * sigmoidf_(y0), y1 * sigmoidf_(y1)); }
          *(GAS v4u*)(XC + (size_t)row * DM + col0) = o; }
      if (extra) { float cwx[3][8], cbx[8]; load_conv_w8(p, colx, cwx, cbx);
          *(LAS v4u*)(lds + (2 * wave + (lane >> 5)) * 528 + 16 * (lane & 31)) = conv_silu8_raw(xa0, xa1, xa2, cwx, cbx); } }
    gate_scalars(p, gw, NGW, lane);
    if (extra) {
        __syncthreads();
        bf16x8 af[8];
#pragma unroll
        for (int ks = 0; ks < 8; ++ks) af[ks] = *(const LAS bf16x8*)(lds + c16 * 528 + (32 * ks + 8 * g) * 2);
#pragma unroll
        for (int t2 = 0; t2 < 2; ++t2) { const int nt = 2 * wave + t2;
            f32x4 acc = (f32x4){0.f, 0.f, 0.f, 0.f};
#pragma unroll
            for (int ks = 0; ks < 8; ++ks) acc = __builtin_amdgcn_mfma_f32_16x16x32_bf16(bfr[t2][ks], af[ks], acc, 0, 0, 0);
            v2u o; o.x = pg8::cvt_pk_safe(acc[0], acc[1]); o.y = pg8::cvt_pk_safe(acc[2], acc[3]);
            *(GAS v2u*)(WSP(bf16, WS_QKM) + (size_t)(MTOK + 16 * rt + c16) * 1024 + hh * 256 + 16 * nt + 4 * g) = o; }
    }
    asm volatile("s_waitcnt vmcnt(0)" ::: "memory"); __syncthreads();
}

struct EpiStoreBf16 {
    static constexpr bool PERM = true; static constexpr int MID_T = -1;
    bf16* O; int ldc;
    __device__ __forceinline__ void operator()(const pg8::f32x4 (&acc)[2][2][4][2], const pg8::Unit& u, int wr, int wc, int fr, int fq) const {
        using namespace pg8;
        const int row0 = u.pm * BM + wr * 64 + fr, col0 = u.pn * BM + wc * 32 + 8 * fq;
#pragma unroll
        for (int ai = 0; ai < 2; ++ai)
#pragma unroll
            for (int m = 0; m < 4; ++m) { bf16* rowp = O + (size_t)(row0 + ai * HALF + m * 16) * ldc + col0;
#pragma unroll
                for (int bj = 0; bj < 2; ++bj) { const f32x4 v0 = acc[ai][bj][m][0], v1 = acc[ai][bj][m][1];
                    u32x4 w; w.x = cvt_pk_bf16(v0[0], v0[1]); w.y = cvt_pk_bf16(v0[2], v0[3]); w.z = cvt_pk_bf16(v1[0], v1[1]); w.w = cvt_pk_bf16(v1[2], v1[3]);
                    *(u32x4*)(rowp + bj * HALF) = w; } }
    }
};
struct EpiMix {
    static constexpr bool PERM = true; static constexpr int MID_T = 16;
    bf16* MIX; const bf16* GA; const bf16* GB;
    __device__ __forceinline__ void mid(pg8::f32x4 (&acc)[2][2][4][2], const pg8::Unit& u, int wr, int wc, int fr, int fq) const {
        using namespace pg8;
        int row0 = u.pm * BM + wr * 64 + fr; const int col0 = u.pn * BM + wc * 32 + 8 * fq;
        asm volatile("" : "+v"(row0));
#pragma unroll
        for (int ai = 0; ai < 2; ++ai)
#pragma unroll
            for (int m2 = 0; m2 < 2; ++m2) { u32x4 a[2][2];
#pragma unroll
                for (int mm = 0; mm < 2; ++mm)
#pragma unroll
                    for (int bj = 0; bj < 2; ++bj) a[mm][bj] = *(const u32x4*)(GA + (size_t)(row0 + ai * HALF + (2 * m2 + mm) * 16) * 1024 + col0 + bj * HALF);
#pragma unroll
                for (int mm = 0; mm < 2; ++mm)
#pragma unroll
                    for (int bj = 0; bj < 2; ++bj) { const u32x4 g4 = a[mm][bj]; f32x4& v0 = acc[ai][bj][2 * m2 + mm][0]; f32x4& v1 = acc[ai][bj][2 * m2 + mm][1];
                        v0[0] *= bflo(g4.x); v0[1] *= bfhi(g4.x); v0[2] *= bflo(g4.y); v0[3] *= bfhi(g4.y); v1[0] *= bflo(g4.z); v1[1] *= bfhi(g4.z); v1[2] *= bflo(g4.w); v1[3] *= bfhi(g4.w); }
                asm volatile("" ::: "memory"); }
    }
    __device__ __forceinline__ void operator()(const pg8::f32x4 (&acc)[2][2][4][2], const pg8::Unit& u, int wr, int wc, int fr, int fq) const {
        using namespace pg8;
        const int row0 = u.pm * BM + wr * 64 + fr, col0 = u.pn * BM + wc * 32 + 8 * fq;
#pragma unroll
        for (int ai = 0; ai < 2; ++ai)
#pragma unroll
            for (int m = 0; m < 4; ++m) { const size_t off = (size_t)(row0 + ai * HALF + m * 16) * 1024 + col0;
#pragma unroll
                for (int bj = 0; bj < 2; ++bj) { const f32x4 v0 = acc[ai][bj][m][0], v1 = acc[ai][bj][m][1];
                    const u32x4 gv = *(const u32x4*)(GB + off + bj * HALF);
                    u32x4 w; w.x = cvt_pk_bf16(v0[0] * bflo(gv.x), v0[1] * bfhi(gv.x)); w.y = cvt_pk_bf16(v0[2] * bflo(gv.y), v0[3] * bfhi(gv.y)); w.z = cvt_pk_bf16(v1[0] * bflo(gv.z), v1[1] * bfhi(gv.z)); w.w = cvt_pk_bf16(v1[2] * bflo(gv.w), v1[3] * bfhi(gv.w));
                    *(u32x4*)(MIX + off + bj * HALF) = w; } }
    }
};
struct EpiOut {
    static constexpr bool PERM = false; static constexpr int MID_T = -1;
    const float* X; float* OUT; bf16* H2B; float* ROWSS;
    __device__ __forceinline__ void operator()(const pg8::f32x4 (&acc)[2][2][4][2], const pg8::Unit& u, int wr, int wc, int fr, int fq) const {
        using namespace pg8;
        const int row0 = u.pm * BM + wr * 64 + fr, col0 = u.pn * BM + wc * 32 + 4 * fq;
#pragma unroll
        for (int ai = 0; ai < 2; ++ai)
#pragma unroll
            for (int m = 0; m < 4; ++m) { const int row = row0 + ai * HALF + m * 16; const size_t off = (size_t)row * 1024 + col0; float ss = 0.f;
#pragma unroll
                for (int bj = 0; bj < 2; ++bj)
#pragma unroll
                    for (int n = 0; n < 2; ++n) { const size_t o2 = off + bj * HALF + n * 16; const f32x4 xv = *(const f32x4*)(X + o2); const f32x4 hv = xv + acc[ai][bj][m][n];
                        ss += (hv[0] * hv[0] + hv[1] * hv[1]) + (hv[2] * hv[2] + hv[3] * hv[3]);
                        u32x2 w; w.x = cvt_pk_bf16(hv[0], hv[1]); w.y = cvt_pk_bf16(hv[2], hv[3]); *(u32x2*)(H2B + o2) = w; }
                ss += __shfl_xor(ss, 16); ss += __shfl_xor(ss, 32);
                if (fq == 0) ROWSS[(size_t)row * 16 + u.pn * 4 + wc] = ss; }
    }
};
struct EpiFF1 {
    static constexpr bool PERM = true; static constexpr int MID_T = -1;
    bf16* HID; const float* ROWSS;
    __device__ __forceinline__ void operator()(const pg8::f32x4 (&acc)[2][2][4][2], const pg8::Unit& u, int wr, int wc, int fr, int fq) const {
        using namespace pg8;
        const int row0 = u.pm * BM + wr * 64 + fr, col0 = u.pn * BM + wc * 32 + 8 * fq;
#pragma unroll
        for (int ai = 0; ai < 2; ++ai)
#pragma unroll
            for (int m = 0; m < 4; ++m) { const int row = row0 + ai * HALF + m * 16;
                const f32x4* rp = (const f32x4*)(ROWSS + (size_t)row * 16); const f32x4 a = rp[0], b = rp[1], c = rp[2], d = rp[3];
                const float tot = ((a[0] + a[1]) + (a[2] + a[3])) + ((b[0] + b[1]) + (b[2] + b[3])) + ((c[0] + c[1]) + (c[2] + c[3])) + ((d[0] + d[1]) + (d[2] + d[3]));
                const float rs = 1.0f / sqrtf(tot * (1.f / 1024.f) + EPS);
                bf16* rowp = HID + (size_t)row * DFF + col0;
#pragma unroll
                for (int bj = 0; bj < 2; ++bj) { f32x4 v0 = acc[ai][bj][m][0] * rs, v1 = acc[ai][bj][m][1] * rs;
#pragma unroll
                    for (int e = 0; e < 4; ++e) { const float z0 = fmaxf(v0[e], 0.f), z1 = fmaxf(v1[e], 0.f); v0[e] = z0 * z0; v1[e] = z1 * z1; }
                    u32x4 w; w.x = cvt_pk_bf16(v0[0], v0[1]); w.y = cvt_pk_bf16(v0[2], v0[3]); w.z = cvt_pk_bf16(v1[0], v1[1]); w.w = cvt_pk_bf16(v1[2], v1[3]);
                    *(u32x4*)(rowp + bj * HALF) = w; } }
    }
};
struct EpiFF2 {
    static constexpr bool PERM = false; static constexpr int MID_T = -1;
    float* OUT; const bf16* H2B;
    __device__ __forceinline__ void operator()(const pg8::f32x4 (&acc)[2][2][4][2], const pg8::Unit& u, int wr, int wc, int fr, int fq) const {
        using namespace pg8;
        const int row0 = u.pm * BM + wr * 64 + fr, col0 = u.pn * BM + wc * 32 + 4 * fq;
#pragma unroll
        for (int ai = 0; ai < 2; ++ai)
#pragma unroll
            for (int m = 0; m < 4; ++m) { const size_t off = (size_t)(row0 + ai * HALF + m * 16) * 1024 + col0;
#pragma unroll
                for (int bj = 0; bj < 2; ++bj)
#pragma unroll
                    for (int n = 0; n < 2; ++n) { const size_t o2 = off + bj * HALF + n * 16; const u32x2 hb = *(const u32x2*)(H2B + o2);
                        *(f32x4*)(OUT + o2) = (f32x4){bflo(hb.x), bfhi(hb.x), bflo(hb.y), bfhi(hb.y)} + acc[ai][bj][m][n]; } }
    }
};

__device__ __forceinline__ s16x4 ds_tr16(const LAS unsigned char* a) { return __builtin_bit_cast(s16x4, __builtin_amdgcn_ds_read_tr16_b64_v4i16((LAS s16x4*)a)); }
__device__ __forceinline__ bf16x8 cat8(s16x4 lo, s16x4 hi) { return (bf16x8){lo[0], lo[1], lo[2], lo[3], hi[0], hi[1], hi[2], hi[3]}; }
__device__ __forceinline__ bf16x8 pack8(const float* f) { v4u w; w.x = pg8::cvt_pk_safe(f[0], f[1]); w.y = pg8::cvt_pk_safe(f[2], f[3]); w.z = pg8::cvt_pk_safe(f[4], f[5]); w.w = pg8::cvt_pk_safe(f[6], f[7]); return __builtin_bit_cast(bf16x8, w); }
constexpr int SC_QP = 272, SC_VP = 80;
constexpr int SC_Q = 0, SC_K = 64 * SC_QP, SC_V = 2 * 64 * SC_QP, SC_S = SC_V + 64 * SC_VP, SC_SF = SC_S + 1280, SC_STAGE = SC_SF + 6144;
constexpr int SC_CIMG = 2 * SC_STAGE;
constexpr int SC_NIMG = SC_CIMG + 16384;
constexpr int SC_MC = SC_NIMG + 8192;
constexpr int SC_FL = SC_MC + 544;
static_assert(SC_FL + 4096 <= LDSCTL_OFF && SC_STAGE % 16 == 0, "scan LDS");
#define SF_BASE(tb) ((tb) == 0 ? 0 : (tb) == 1 ? 1 : (tb) == 2 ? 2 : 4)
#define SCHED_FENCE() __builtin_amdgcn_sched_barrier(0)
constexpr int FACW = 320;

__device__ __forceinline__ void scan_setup(const Ptrs& p, LAS unsigned char* lds, int item, int wid, int lane) {
    const int seq = item >> 3;
    const float* SB = WSP(float, WS_SCAL) + (size_t)seq * NCHUNK * 64; const float* SPM = SB + 2 * SCAL_ARR;
    if (wid == 0) {
        const float b63a = SB[(size_t)lane * 64 + 63], p63a = SPM[(size_t)lane * 64 + 63], b63b = SB[(size_t)64 * 64 + 63], p63b = SPM[(size_t)64 * 64 + 63];
        float m = 0.f;
        for (int c = 0; c < 65; ++c) {
            const int cl = c & 63;
            const float bb = (c < 64) ? __builtin_bit_cast(float, __builtin_amdgcn_readlane(__builtin_bit_cast(int, b63a), cl)) : b63b, pp = (c < 64) ? __builtin_bit_cast(float, __builtin_amdgcn_readlane(__builtin_bit_cast(int, p63a), cl)) : p63b;
            const float M63 = fmaxf(m, pp);
            if (lane == 0) { ((LAS float*)(lds + SC_MC))[c] = m; ((LAS float*)(lds + SC_MC))[68 + c] = M63; }
            m = bb + M63; }
    }
    __syncthreads();
}
__device__ __forceinline__ void scan_prepass(const Ptrs& p, LAS unsigned char* lds, int item, int wid, int lane) {
    using pg8::f32x4;
    const int seq = item >> 3, sl = item & 7, dir = seq & 1, h = (seq >> 1) & 3, b = seq >> 3, c16 = lane & 15, g = lane >> 4;
    const int c = 8 * wid + sl, nsteps = dir ? 64 : 65;
    const bool active = c < nsteps && !(dir == 0 && c == 0);
    for (int cc = c; cc < nsteps; cc += 64) {
        if (!(cc < nsteps) || (dir == 0 && cc == 0)) continue;
        const float* SG = WSP(float, WS_SCAL) + SCAL_ARR + (size_t)seq * NCHUNK * 64;
        LAS float* Fl = (LAS float*)(lds + SC_FL + wid * 512);
        { const float* SBq = WSP(float, WS_SCAL) + (size_t)seq * NCHUNK * 64; const float* SPMq = SBq + 2 * SCAL_ARR;
          const float mc = ((const LAS float*)(lds + SC_MC))[cc], M63 = ((const LAS float*)(lds + SC_MC))[68 + cc];
          const float Mt = fmaxf(mc, SPMq[(size_t)cc * 64 + lane]);
          const float Fv = __expf(SG[(size_t)cc * 64 + lane] - M63), Rv = __expf(fminf(M63 - Mt, 80.f));
          Fl[lane] = Fv; Fl[64 + lane] = Rv;
          float* FAC = WSP(float, WS_FAC) + (size_t)(seq * 64 + (dir ? cc : cc - 1)) * FACW;
          FAC[lane] = Fv; FAC[64 + lane] = Rv; FAC[128 + lane] = __expf(mc - Mt); FAC[192 + lane] = __expf(-(SBq[(size_t)cc * 64 + lane] + Mt)); }
        LDS_WAIT(); asm volatile("" ::: "memory");
        const bf16* QKM = WSP(bf16, WS_QKM);
        auto rowp = [&](int t) -> const bf16* { const int l = dir ? (LSEQ - 1 - 64 * cc - t) : (64 * cc + t - 48); return QKM + ((size_t)b * LSEQ + l) * 1024 + h * 256 + 8 * g; };
        v4u* SF = (v4u*)(p.ws + WS_SFRAG) + ((size_t)(seq * 64 + (dir ? cc : cc - 1)) * 6) * 64 + lane;
        bf16x8 qa[4][4], ka[4][4];
#pragma unroll
        for (int tb = 0; tb < 4; ++tb) { const bf16* qp = rowp(16 * tb + c16);
#pragma unroll
            for (int ks = 0; ks < 4; ++ks) { qa[tb][ks] = *(const GAS bf16x8*)(qp + 32 * ks); ka[tb][ks] = *(const GAS bf16x8*)(qp + 128 + 32 * ks); } }
#pragma unroll
        for (int tb = 0; tb < 4; ++tb) {
            f32x4 X[4]; float rsum = 0.f;
#pragma unroll
            for (int sb = 0; sb <= tb; ++sb) {
                f32x4 x = (f32x4){0.f, 0.f, 0.f, 0.f};
#pragma unroll
                for (int ks = 0; ks < 4; ++ks) x = __builtin_amdgcn_mfma_f32_16x16x32_bf16(ka[sb][ks], qa[tb][ks], x, 0, 0, 0);
                const f32x4 F4 = *(const LAS f32x4*)(Fl + 16 * sb + 4 * g);
#pragma unroll
                for (int r = 0; r < 4; ++r) { float v = x[r]; if (sb == tb) v = (4 * g + r <= c16) ? v : 0.f; x[r] = v; rsum += v * F4[r]; }
                X[sb] = x; }
            rsum += __shfl_xor(rsum, 16); rsum += __shfl_xor(rsum, 32);
            if (g == 0) { float* FAC = WSP(float, WS_FAC) + (size_t)(seq * 64 + (dir ? cc : cc - 1)) * FACW; FAC[256 + 16 * tb + c16] = Fl[64 + 16 * tb + c16] * rsum; }
#pragma unroll
            for (int k2 = 0; 2 * k2 <= tb; ++k2) { float sf[8];
#pragma unroll
                for (int j = 0; j < 4; ++j) { sf[j] = X[2 * k2][j]; sf[4 + j] = (2 * k2 + 1 <= tb) ? X[(2 * k2 + 1 <= tb) ? 2 * k2 + 1 : 0][j] : 0.f; }
                SF[(SF_BASE(tb) + k2) * 64] = __builtin_bit_cast(v4u, pack8(sf)); }
        }
        LDS_WAIT(); asm volatile("" ::: "memory");
    }
    (void)active;
}
__device__ __forceinline__ void scan_B(const Ptrs& p, LAS unsigned char* lds, int item, int tid, int wid, int lane) {
    using pg8::f32x4;
    const int seq = item >> 3, sl = item & 7, dir = seq & 1, h = (seq >> 1) & 3, b = seq >> 3;
    const int nsteps = dir ? 64 : 65;
    const int c16 = lane & 15, g = lane >> 4;
    const float* SB = WSP(float, WS_SCAL) + (size_t)seq * NCHUNK * 64; const float* SG = SB + SCAL_ARR; const float* SPM = SG + SCAL_ARR;
    const int qrow0 = (tid >> 4) & 15, qc = tid & 15;
    const int vrow = (tid >> 2) & 63, vpc = tid & 3;
    const int farr = (tid >> 6) & 3, ft = tid & 63;
    const long long rstep = dir ? -64 : 64;
    auto row_l = [&](int c, int t) -> int { return dir ? (LSEQ - 1 - 64 * c - t) : (64 * c + t - 48); };
    const bf16* qkp; const bf16* vp;
    { const bf16* QKM = WSP(bf16, WS_QKM); const bf16* XM = WSP(bf16, WS_XM);
      qkp = QKM + ((size_t)b * LSEQ + row_l(1, qrow0)) * 1024 + h * 256 + 8 * qc;
      vp = XM + ((size_t)b * LSEQ + row_l(1, vrow)) * 1024 + h * 256 + 32 * sl + 8 * vpc; }
    const long long r16 = dir ? -16 * 1024 : 16 * 1024;
    v4u rq[4], rk[4], rv, rs0, rs1 = {0, 0, 0, 0}; float rx1 = 0.f, rx2 = 0.f, rfv = 0.f;
    const float* facb = WSP(float, WS_FAC) + ((size_t)seq * 64 - (dir ? 0 : 1)) * FACW;
    const v4u* sfp = (const v4u*)(p.ws + WS_SFRAG) + ((size_t)seq * 64 - (dir ? 0 : 1)) * 384 + tid;
    auto issue = [&](int c) {
        const long long off = (long long)(c - 1) * rstep * 1024;
#pragma unroll
        for (int i = 0; i < 4; ++i) { rq[i] = *(const GAS v4u*)(qkp + off + i * r16); rk[i] = *(const GAS v4u*)(qkp + off + i * r16 + 128); }
        rv = *(const GAS v4u*)(vp + off);
        rx1 = facb[(size_t)c * FACW + tid]; rfv = facb[(size_t)c * FACW + vrow]; if (tid >= 128 && tid < 192) rx2 = facb[(size_t)c * FACW + 128 + tid];
        rs0 = *(const GAS v4u*)(sfp + (size_t)c * 384); if (tid < 128) rs1 = *(const GAS v4u*)(sfp + (size_t)c * 384 + 256);
    };
    auto commit = [&](int c, int stage) {
        LAS unsigned char* S = lds + stage * SC_STAGE;
#pragma unroll
        for (int i = 0; i < 4; ++i) { const int t = qrow0 + 16 * i; *(LAS v4u*)(S + SC_Q + t * SC_QP + 16 * qc) = rq[i]; *(LAS v4u*)(S + SC_K + t * SC_QP + 16 * qc) = rk[i]; }
        { v4u fv;
          fv.x = pg8::cvt_pk_safe(bflo(rv.x) * rfv, bfhi(rv.x) * rfv); fv.y = pg8::cvt_pk_safe(bflo(rv.y) * rfv, bfhi(rv.y) * rfv); fv.z = pg8::cvt_pk_safe(bflo(rv.z) * rfv, bfhi(rv.z) * rfv); fv.w = pg8::cvt_pk_safe(bflo(rv.w) * rfv, bfhi(rv.w) * rfv);
          *(LAS v4u*)(S + SC_V + vrow * SC_VP + 16 * vpc) = fv; }
        *(LAS v4u*)(S + SC_SF + tid * 16) = rs0; if (tid < 128) *(LAS v4u*)(S + SC_SF + (256 + tid) * 16) = rs1;
        *(LAS float*)(S + SC_S + tid * 4) = rx1; if (tid >= 128 && tid < 192) *(LAS float*)(S + SC_S + (128 + tid) * 4) = rx2;
    };
    { const bf16* QKM = WSP(bf16, WS_QKM); const bf16* XM = WSP(bf16, WS_XM);
#pragma unroll
      for (int i = 0; i < 4; ++i) { const int l = row_l(0, qrow0 + 16 * i); rq[i] = (v4u){0, 0, 0, 0}; rk[i] = (v4u){0, 0, 0, 0};
          if (l >= 0) { const bf16* src = QKM + ((size_t)b * LSEQ + l) * 1024 + h * 256 + 8 * qc; rq[i] = *(const GAS v4u*)src; rk[i] = *(const GAS v4u*)(src + 128); } }
      rv = (v4u){0, 0, 0, 0};
      { const int l = row_l(0, vrow); if (l >= 0) rv = *(const GAS v4u*)(XM + ((size_t)b * LSEQ + l) * 1024 + h * 256 + 32 * sl + 8 * vpc); }
      { const float x1 = (farr == 0 ? SG : SPM)[ft], x2 = (farr == 3) ? SB[ft] : 0.f;
        const float mc = ((const LAS float*)(lds + SC_MC))[0], M63 = ((const LAS float*)(lds + SC_MC))[68], Mt = fmaxf(mc, x1);
        if (farr == 0) rx1 = __expf(x1 - M63); else if (farr == 1) rx1 = __expf(fminf(M63 - Mt, 80.f)); else if (farr == 2) rx1 = __expf(mc - Mt); else rx1 = __expf(-(x2 + Mt));
        rfv = __expf(SG[vrow] - M63);
        if (dir && tid >= 128 && tid < 192) rx2 = facb[128 + tid]; }
      rs0 = (v4u){0, 0, 0, 0}; if (dir) { rs0 = *(const GAS v4u*)sfp; if (tid < 128) rs1 = *(const GAS v4u*)(sfp + 256); }
      commit(0, 0); }
    __syncthreads();
    f32x4 Cs[2][2], Ns[2];
#pragma unroll
    for (int i = 0; i < 2; ++i) { Ns[i] = (f32x4){0.f, 0.f, 0.f, 0.f}; Cs[0][i] = Ns[i]; Cs[1][i] = Ns[i]; }
    const int ktr_off = (8 * g + (c16 >> 2)) * SC_QP + 8 * (c16 & 3) + 32 * (2 * wid);
    const int vtr_off = ((c16 >> 2)) * SC_VP + 8 * (c16 & 3);
    for (int c = 0; c < nsteps; ++c) {
        const int st = c & 1;
        if (c + 1 < nsteps) issue(c + 1);
        const LAS unsigned char* S = lds + st * SC_STAGE;
        const LAS unsigned char* Ks = S + SC_K; const LAS unsigned char* Vs = S + SC_V;
        const LAS float* fF = (const LAS float*)(S + SC_S); const LAS float* fW = fF + 128;
        f32x4 gf[2][2]; s16x4 bvlo[2][2], bvhi[2][2], klo[2][2], khi[2][2];
#pragma unroll
        for (int ks = 0; ks < 2; ++ks) { gf[ks][0] = *(const LAS f32x4*)(fF + 32 * ks + 8 * g); gf[ks][1] = *(const LAS f32x4*)(fF + 32 * ks + 8 * g + 4); }
#pragma unroll
        for (int eb = 0; eb < 2; ++eb)
#pragma unroll
            for (int ks = 0; ks < 2; ++ks) { const LAS unsigned char* va = Vs + vtr_off + 32 * eb + (32 * ks + 8 * g) * SC_VP; bvlo[eb][ks] = ds_tr16(va); bvhi[eb][ks] = ds_tr16(va + 4 * SC_VP); }
#pragma unroll
        for (int d2 = 0; d2 < 2; ++d2)
#pragma unroll
            for (int ks = 0; ks < 2; ++ks) { const LAS unsigned char* ka = Ks + ktr_off + 32 * ks * SC_QP + 32 * d2; klo[d2][ks] = ds_tr16(ka); khi[d2][ks] = ds_tr16(ka + 4 * SC_QP); }
        const float decay = fW[63];
        SCHED_FENCE();
        bf16x8 Bf[2][2], Fb[2];
#pragma unroll
        for (int ks = 0; ks < 2; ++ks) { float ff[8];
#pragma unroll
            for (int j = 0; j < 4; ++j) { ff[j] = gf[ks][0][j]; ff[4 + j] = gf[ks][1][j]; }
            Fb[ks] = pack8(ff);
#pragma unroll
            for (int eb = 0; eb < 2; ++eb) Bf[eb][ks] = cat8(bvlo[eb][ks], bvhi[eb][ks]); }
#pragma unroll
        for (int d2 = 0; d2 < 2; ++d2) { Cs[0][d2] *= decay; Cs[1][d2] *= decay; Ns[d2] *= decay; }
#pragma unroll
        for (int ks = 0; ks < 2; ++ks)
#pragma unroll
            for (int d2 = 0; d2 < 2; ++d2) { const bf16x8 A = cat8(klo[d2][ks], khi[d2][ks]);
                Cs[0][d2] = __builtin_amdgcn_mfma_f32_16x16x32_bf16(A, Bf[0][ks], Cs[0][d2], 0, 0, 0);
                Cs[1][d2] = __builtin_amdgcn_mfma_f32_16x16x32_bf16(A, Bf[1][ks], Cs[1][d2], 0, 0, 0);
                Ns[d2] = __builtin_amdgcn_mfma_f32_16x16x32_bf16(A, Fb[ks], Ns[d2], 0, 0, 0); }
#pragma unroll
        for (int eb = 0; eb < 2; ++eb) { const float cfv[8] = {Cs[eb][0][0], Cs[eb][0][1], Cs[eb][0][2], Cs[eb][0][3], Cs[eb][1][0], Cs[eb][1][1], Cs[eb][1][2], Cs[eb][1][3]};
            *(LAS bf16x8*)(lds + SC_CIMG + (st ^ 1) * 8192 + (eb * 4 + wid) * 1024 + lane * 16) = pack8(cfv); }
        { const float nfv[8] = {Ns[0][0], Ns[0][1], Ns[0][2], Ns[0][3], Ns[1][0], Ns[1][1], Ns[1][2], Ns[1][3]};
          *(LAS bf16x8*)(lds + SC_NIMG + (st ^ 1) * 4096 + wid * 1024 + lane * 16) = pack8(nfv); }
        if (c + 1 < nsteps) commit(c + 1, st ^ 1);
        asm volatile("s_waitcnt lgkmcnt(0)" ::: "memory"); __builtin_amdgcn_s_barrier(); asm volatile("" ::: "memory");
    }
}
template <int TB>
__device__ __forceinline__ void scan_A(const Ptrs& p, LAS unsigned char* lds, int item, int lane) {
    using pg8::f32x4;
    const int seq = item >> 3, sl = item & 7, dir = seq & 1, h = (seq >> 1) & 3, b = seq >> 3;
    const int nsteps = dir ? 64 : 65;
    const int c16 = lane & 15, g = lane >> 4;
    auto row_l = [&](int c, int t) -> int { return dir ? (LSEQ - 1 - 64 * c - t) : (64 * c + t - 48); };
    __syncthreads();
    const int qrow_off = (16 * TB + c16) * SC_QP;
    const int vtr_off = ((c16 >> 2)) * SC_VP + 8 * (c16 & 3);
    bf16* hop = (dir ? WSP(bf16, WS_HB) : WSP(bf16, WS_HF)) + ((size_t)b * SEQ + (row_l(1, 16 * TB + c16) - NMETA)) * 1024 + h * 256 + 32 * sl + 4 * g;
    const long long rstep = dir ? -64 : 64;
    constexpr int NK2 = (TB >= 2) ? 2 : 1;
    for (int c = 0; c < nsteps; ++c) {
        const int st = c & 1;
        const LAS unsigned char* S = lds + st * SC_STAGE;
        const LAS unsigned char* Qs = S + SC_Q; const LAS unsigned char* Vs = S + SC_V;
        const LAS float* fF = (const LAS float*)(S + SC_S); const LAS float* fR = fF + 64; const LAS float* fW = fF + 128; const LAS float* fE = fF + 192; const LAS float* fQ = fF + 256;
        bf16x8 cf[2][4], nf[4], sfr[NK2]; v2u qlo[4], qhi[4]; s16x4 svlo[2][NK2], svhi[2][NK2];
#pragma unroll
        for (int kk = 0; kk < 4; ++kk) { cf[0][kk] = *(const LAS bf16x8*)(lds + SC_CIMG + st * 8192 + kk * 1024 + lane * 16); cf[1][kk] = *(const LAS bf16x8*)(lds + SC_CIMG + st * 8192 + (4 + kk) * 1024 + lane * 16);
            nf[kk] = *(const LAS bf16x8*)(lds + SC_NIMG + st * 4096 + kk * 1024 + lane * 16); }
#pragma unroll
        for (int kk = 0; kk < 4; ++kk) { qlo[kk] = *(const LAS v2u*)(Qs + qrow_off + 64 * kk + 8 * g); qhi[kk] = *(const LAS v2u*)(Qs + qrow_off + 64 * kk + 32 + 8 * g); }
#pragma unroll
        for (int k2 = 0; k2 < NK2; ++k2) sfr[k2] = *(const LAS bf16x8*)(S + SC_SF + (SF_BASE(TB) + k2) * 1024 + lane * 16);
#pragma unroll
        for (int eb = 0; eb < 2; ++eb)
#pragma unroll
            for (int k2 = 0; k2 < NK2; ++k2) { const LAS unsigned char* va = Vs + vtr_off + 32 * eb + (32 * k2 + 4 * g) * SC_VP; svlo[eb][k2] = ds_tr16(va); svhi[eb][k2] = ds_tr16(va + 16 * SC_VP); }
        const float Rt = fR[16 * TB + c16], Wt = fW[16 * TB + c16], Et = fE[16 * TB + c16], Qt = fQ[16 * TB + c16];
        SCHED_FENCE();
        f32x4 P0 = (f32x4){0.f, 0.f, 0.f, 0.f}, P1 = P0, Pn = P0, Sv0 = P0, Sv1 = P0;
#pragma unroll
        for (int kk = 0; kk < 4; ++kk) { const bf16x8 A = __builtin_bit_cast(bf16x8, (v4u){qlo[kk].x, qlo[kk].y, qhi[kk].x, qhi[kk].y});
            P0 = __builtin_amdgcn_mfma_f32_16x16x32_bf16(cf[0][kk], A, P0, 0, 0, 0); P1 = __builtin_amdgcn_mfma_f32_16x16x32_bf16(cf[1][kk], A, P1, 0, 0, 0);
            Pn = __builtin_amdgcn_mfma_f32_16x16x32_bf16(nf[kk], A, Pn, 0, 0, 0); }
#pragma unroll
        for (int k2 = 0; k2 < NK2; ++k2) {
            Sv0 = __builtin_amdgcn_mfma_f32_16x16x32_bf16(cat8(svlo[0][k2], svhi[0][k2]), sfr[k2], Sv0, 0, 0, 0);
            Sv1 = __builtin_amdgcn_mfma_f32_16x16x32_bf16(cat8(svlo[1][k2], svhi[1][k2]), sfr[k2], Sv1, 0, 0, 0); }
        if (!(dir == 0 && c == 0)) {
            bf16* op = hop + (long long)(c - 1) * rstep * 1024;
            const float den = Wt * Pn[0] + Qt, inv = __builtin_amdgcn_rcpf(fmaxf(fabsf(den), Et)), wi = Wt * inv, ri = Rt * inv;
            v2u o0, o1;
            o0.x = pg8::cvt_pk_safe(wi * P0[0] + ri * Sv0[0], wi * P0[1] + ri * Sv0[1]); o0.y = pg8::cvt_pk_safe(wi * P0[2] + ri * Sv0[2], wi * P0[3] + ri * Sv0[3]);
            o1.x = pg8::cvt_pk_safe(wi * P1[0] + ri * Sv1[0], wi * P1[1] + ri * Sv1[1]); o1.y = pg8::cvt_pk_safe(wi * P1[2] + ri * Sv1[2], wi * P1[3] + ri * Sv1[3]);
            *(GAS v2u*)op = o0; *(GAS v2u*)(op + 16) = o1; }
        asm volatile("s_waitcnt lgkmcnt(0)" ::: "memory"); __builtin_amdgcn_s_barrier(); asm volatile("" ::: "memory");
    }
}
__device__ __forceinline__ void scan_zero_images(LAS unsigned char* lds, int tid) { for (int i = tid; i < (16384 + 8192) / 4; i += NTHR) *(LAS unsigned*)(lds + SC_CIMG + i * 4) = 0u; }
__device__ __forceinline__ void scan_item(const Ptrs& p, LAS unsigned char* lds, int item, int tid, int wid, int lane, int flags) {
    (void)flags;
    switch (wid) {
        case 0: case 1: case 2: case 3: scan_B(p, lds, item, tid, wid, lane); break;
        case 4: scan_A<0>(p, lds, item, lane); break;
        case 5: scan_A<1>(p, lds, item, lane); break;
        case 6: scan_A<2>(p, lds, item, lane); break;
        default: scan_A<3>(p, lds, item, lane); break;
    }
}

constexpr int NA_KR = 0, NA_VR = 65536, NA_KM = 131072, NA_VM = 133120, NA_RPB = 135168;
static_assert(NA_RPB + 4 * 15 * 32 * 4 <= LDSCTL_OFF, "NA LDS");
__device__ __forceinline__ int na_r0(int r) { return min(max(r - 4, 0), 56); }
__device__ __forceinline__ void na_block(const Ptrs& p, LAS unsigned char* lds, int item, int tid, int wave, int lane) {
    using pg8::f32x4;
    const int rb = item & 7, bh = item >> 3, h = bh & 7, b = bh >> 3;
    const int c16 = lane & 15, g = lane >> 4, seg = wave & 3, eh = wave >> 2;
    const bf16* QN = WSP(bf16, WS_QN); const bf16* KN = WSP(bf16, WS_KN); const bf16* VR = WSP(bf16, WS_VR); bf16* YB = WSP(bf16, WS_YB);
    const int st_r = tid >> 3, st_c = tid & 7;
    const int st_dst = st_r * 128 + ((st_c ^ ((st_r >> 1) & 7)) << 4);
    const bf16* ksrc = KN + ((size_t)b * LSEQ + NMETA + st_r) * NAI + h * 64 + 8 * st_c;
    const bf16* vsrc = VR + ((size_t)b * LSEQ + NMETA + st_r) * NAI + h * 64 + 8 * st_c;
    if (tid < 128) *(LAS v4u*)(lds + NA_KM + st_dst) = *(const GAS v4u*)(KN + ((size_t)b * LSEQ + st_r) * NAI + h * 64 + 8 * st_c);
    else if (tid < 256) { const int t2 = tid - 128; *(LAS v4u*)(lds + NA_VM + (t2 >> 3) * 128 + (((t2 & 7) ^ (((t2 >> 3) >> 1) & 7)) << 4)) = *(const GAS v4u*)(VR + ((size_t)b * LSEQ + (t2 >> 3)) * NAI + h * 64 + 8 * (t2 & 7)); }
    for (int i = tid; i < 4 * 15 * 32; i += NTHR) { const int s = i / 480, rem = i - s * 480, dr = rem >> 5, j = (rem & 31) + s;
        ((LAS float*)(lds + NA_RPB))[i] = (j < 31) ? p.rpb[h * 465 + dr * 31 + j] * 1.4426950408889634f : 0.f; }
    const int rfirst = 8 * rb, w0 = na_r0(rfirst);
#pragma unroll
    for (int half = 0; half < 2; ++half) {
        v4u kq[4], vq[4];
#pragma unroll
        for (int j = 0; j < 4; ++j) { const int kr = w0 + 4 * half + j; kq[j] = *(const GAS v4u*)(ksrc + (size_t)kr * 64 * NAI); vq[j] = *(const GAS v4u*)(vsrc + (size_t)kr * 64 * NAI); }
#pragma unroll
        for (int j = 0; j < 4; ++j) { const int sl = (w0 + 4 * half + j) & 7; *(LAS v4u*)(lds + NA_KR + sl * 8192 + st_dst) = kq[j]; *(LAS v4u*)(lds + NA_VR + sl * 8192 + st_dst) = vq[j]; }
    }
    __syncthreads();
    const int reg0 = min(max(16 * seg - 8, 0), 32);
    const int qcol = 16 * seg + c16, win0 = min(max(qcol - 8, 0), 48);
    const int dcb = reg0 + 4 * g - qcol + 15, bsh = dcb & 3;
    const LAS unsigned char* bias_base = lds + NA_RPB + (bsh * 480 + (dcb - bsh)) * 4;
    unsigned vmask = 0u;
#pragma unroll
    for (int ct = 0; ct < 2; ++ct)
#pragma unroll
        for (int q = 0; q < 4; ++q) { const int kcol = reg0 + 16 * ct + 4 * g + q; if (kcol >= win0 && kcol < win0 + 16) vmask |= 1u << (4 * ct + q); }
    float mb4[4];
#pragma unroll
    for (int q = 0; q < 4; ++q) mb4[q] = p.mbias[h * 16 + 4 * g + q] * 1.4426950408889634f;
    int koff[2][2];
#pragma unroll
    for (int ct = 0; ct < 2; ++ct)
#pragma unroll
        for (int ks = 0; ks < 2; ++ks) { const int tok = reg0 + 16 * ct + c16; koff[ct][ks] = tok * 128 + (((g + 4 * ks) ^ ((tok >> 1) & 7)) << 4); }
    int voff[2][2];
#pragma unroll
    for (int e2 = 0; e2 < 2; ++e2)
#pragma unroll
        for (int hl = 0; hl < 2; ++hl) { const int tok = reg0 + 16 * hl + 4 * g + (c16 >> 2), ch = 2 * (2 * eh + e2) + ((c16 & 3) >> 1); voff[e2][hl] = tok * 128 + ((ch ^ ((tok >> 1) & 7)) << 4) + 8 * (c16 & 1); }
    int vmoff[2];
#pragma unroll
    for (int e2 = 0; e2 < 2; ++e2) { const int tok = 4 * g + (c16 >> 2), ch = 2 * (2 * eh + e2) + ((c16 & 3) >> 1); vmoff[e2] = tok * 128 + ((ch ^ ((tok >> 1) & 7)) << 4) + 8 * (c16 & 1); }
    const int kmoff0 = c16 * 128 + ((g ^ ((c16 >> 1) & 7)) << 4), kmoff1 = c16 * 128 + (((g + 4) ^ ((c16 >> 1) & 7)) << 4);
    bf16x8 qn_[2];
    { const bf16* qp = QN + ((size_t)b * LSEQ + NMETA + rfirst * 64 + qcol) * NAI + h * 64 + 8 * g; qn_[0] = *(const GAS bf16x8*)qp; qn_[1] = *(const GAS bf16x8*)(qp + 32); }
    for (int rr8 = 0; rr8 < 8; ++rr8) {
        const int r = rfirst + rr8, r0 = na_r0(r);
        const bool have_new = (rr8 < 7) && (na_r0(r + 1) != r0);
        const int newrow = r0 + 8;
        v4u nk = {0, 0, 0, 0}, nv = {0, 0, 0, 0};
        if (have_new) { nk = *(const GAS v4u*)(ksrc + (size_t)newrow * 64 * NAI); nv = *(const GAS v4u*)(vsrc + (size_t)newrow * 64 * NAI); }
        const bf16x8 qf[2] = {qn_[0], qn_[1]};
        if (rr8 < 7) { const bf16* qp = QN + ((size_t)b * LSEQ + NMETA + (r + 1) * 64 + qcol) * NAI + h * 64 + 8 * g; qn_[0] = *(const GAS bf16x8*)qp; qn_[1] = *(const GAS bf16x8*)(qp + 32); }
        f32x4 X[17];
#pragma unroll
        for (int kr = 0; kr < 8; ++kr) { const LAS unsigned char* ks_ = lds + NA_KR + ((r0 + kr) & 7) * 8192;
#pragma unroll
            for (int ct = 0; ct < 2; ++ct) { const bf16x8 k0 = *(const LAS bf16x8*)(ks_ + koff[ct][0]), k1 = *(const LAS bf16x8*)(ks_ + koff[ct][1]);
                f32x4 x = __builtin_amdgcn_mfma_f32_16x16x32_bf16(k0, qf[0], (f32x4){0.f, 0.f, 0.f, 0.f}, 0, 0, 0);
                X[2 * kr + ct] = __builtin_amdgcn_mfma_f32_16x16x32_bf16(k1, qf[1], x, 0, 0, 0); } }
        { const bf16x8 k0 = *(const LAS bf16x8*)(lds + NA_KM + kmoff0), k1 = *(const LAS bf16x8*)(lds + NA_KM + kmoff1);
          f32x4 x = __builtin_amdgcn_mfma_f32_16x16x32_bf16(k0, qf[0], (f32x4){0.f, 0.f, 0.f, 0.f}, 0, 0, 0);
          X[16] = __builtin_amdgcn_mfma_f32_16x16x32_bf16(k1, qf[1], x, 0, 0, 0); }
        float mx = -INFINITY;
        const LAS unsigned char* brow = bias_base + (r0 - r + 7) * 128;
#pragma unroll
        for (int i = 0; i < 16; ++i) { const f32x4 bv = *(const LAS f32x4*)(brow + (i >> 1) * 128 + (i & 1) * 64);
#pragma unroll
            for (int q = 0; q < 4; ++q) { const float v = ((vmask >> (4 * (i & 1) + q)) & 1u) ? X[i][q] + bv[q] : -INFINITY; X[i][q] = v; mx = fmaxf(mx, v); } }
#pragma unroll
        for (int q = 0; q < 4; ++q) { const float v = X[16][q] + mb4[q]; X[16][q] = v; mx = fmaxf(mx, v); }
        mx = fmaxf(mx, __shfl_xor(mx, 16)); mx = fmaxf(mx, __shfl_xor(mx, 32));
        float sum = 0.f;
#pragma unroll
        for (int i = 0; i < 17; ++i)
#pragma unroll
            for (int q = 0; q < 4; ++q) { const float e = __builtin_amdgcn_exp2f(X[i][q] - mx); X[i][q] = e; sum += e; }
        sum += __shfl_xor(sum, 16); sum += __shfl_xor(sum, 32);
        const float inv = 1.0f / sum;
        f32x4 O[2] = {(f32x4){0.f, 0.f, 0.f, 0.f}, (f32x4){0.f, 0.f, 0.f, 0.f}};
#pragma unroll
        for (int kk = 0; kk < 8; ++kk) {
            float pf[8];
#pragma unroll
            for (int j = 0; j < 4; ++j) { pf[j] = X[2 * kk][j]; pf[4 + j] = X[2 * kk + 1][j]; }
            const bf16x8 A = pack8(pf);
            const LAS unsigned char* vs_ = lds + NA_VR + ((r0 + kk) & 7) * 8192;
#pragma unroll
            for (int e2 = 0; e2 < 2; ++e2) { const s16x4 lo = ds_tr16(vs_ + voff[e2][0]), hi = ds_tr16(vs_ + voff[e2][1]);
                O[e2] = __builtin_amdgcn_mfma_f32_16x16x32_bf16(A, cat8(lo, hi), O[e2], 0, 0, 0); } }
        { float pf[8];
#pragma unroll
          for (int j = 0; j < 4; ++j) { pf[j] = X[16][j]; pf[4 + j] = 0.f; }
          const bf16x8 A = pack8(pf);
#pragma unroll
          for (int e2 = 0; e2 < 2; ++e2) { const s16x4 lo = ds_tr16(lds + NA_VM + vmoff[e2]); const s16x4 z = {0, 0, 0, 0};
              O[e2] = __builtin_amdgcn_mfma_f32_16x16x32_bf16(A, cat8(lo, z), O[e2], 0, 0, 0); } }
#pragma unroll
        for (int q = 0; q < 4; ++q) { const float iv = __shfl(inv, 4 * g + q); bf16* op = YB + ((size_t)b * SEQ + r * 64 + 16 * seg + 4 * g + q) * NAI + h * 64 + 32 * eh + c16;
            op[0] = (bf16)f2bf(O[0][q] * iv); op[16] = (bf16)f2bf(O[1][q] * iv); }
        __syncthreads();
        if (have_new) { const int sl = newrow & 7; *(LAS v4u*)(lds + NA_KR + sl * 8192 + st_dst) = nk; *(LAS v4u*)(lds + NA_VR + sl * 8192 + st_dst) = nv; }
        __syncthreads();
    }
}

__device__ __forceinline__ void na_sync4(LAS unsigned* cnt, unsigned& epoch, int lane) {
    epoch += 4u;
    asm volatile("s_waitcnt lgkmcnt(0)" ::: "memory");
    if (lane == 0) __hip_atomic_fetch_add(cnt, 1u, __ATOMIC_RELAXED, __HIP_MEMORY_SCOPE_WORKGROUP);
    unsigned sp = 0;
    while ((unsigned)__builtin_amdgcn_readfirstlane((int)__hip_atomic_load(cnt, __ATOMIC_RELAXED, __HIP_MEMORY_SCOPE_WORKGROUP)) < epoch) { __builtin_amdgcn_s_sleep(0); if (++sp > (1u << 24)) break; }
    asm volatile("" ::: "memory");
}
__device__ __forceinline__ void na_block4(const Ptrs& p, LAS unsigned char* lds, int item, int tid4, int seg, int lane) {
    using pg8::f32x4;
    const int rb = item & 7, bh = item >> 3, h = bh & 7, b = bh >> 3;
    const int c16 = lane & 15, g = lane >> 4;
    LAS unsigned* cnt = (LAS unsigned*)(lds + MISC_OFF + 64); unsigned epoch = 0u;
    const bf16* QN = WSP(bf16, WS_QN); const bf16* KN = WSP(bf16, WS_KN); const bf16* VR = WSP(bf16, WS_VR); bf16* YB = WSP(bf16, WS_YB);
    const int st_r = tid4 >> 3, st_c = tid4 & 7;
    const int st_dst = st_r * 128 + ((st_c ^ ((st_r >> 1) & 7)) << 4), st_dst2 = (st_r + 32) * 128 + ((st_c ^ (((st_r + 32) >> 1) & 7)) << 4);
    const size_t st_2nd = (size_t)32 * NAI;
    const bf16* ksrc = KN + ((size_t)b * LSEQ + NMETA + st_r) * NAI + h * 64 + 8 * st_c;
    const bf16* vsrc = VR + ((size_t)b * LSEQ + NMETA + st_r) * NAI + h * 64 + 8 * st_c;
    if (tid4 < 128) *(LAS v4u*)(lds + NA_KM + st_dst) = *(const GAS v4u*)(KN + ((size_t)b * LSEQ + st_r) * NAI + h * 64 + 8 * st_c);
    { const int t2 = tid4 & 127; if (tid4 >= 128) *(LAS v4u*)(lds + NA_VM + (t2 >> 3) * 128 + (((t2 & 7) ^ (((t2 >> 3) >> 1) & 7)) << 4)) = *(const GAS v4u*)(VR + ((size_t)b * LSEQ + (t2 >> 3)) * NAI + h * 64 + 8 * (t2 & 7)); }
    for (int i = tid4; i < 4 * 15 * 32; i += 256) { const int s = i / 480, rem = i - s * 480, dr = rem >> 5, j = (rem & 31) + s;
        ((LAS float*)(lds + NA_RPB))[i] = (j < 31) ? p.rpb[h * 465 + dr * 31 + j] * 1.4426950408889634f : 0.f; }
    const int rfirst = 8 * rb, w0 = na_r0(rfirst);
    { v4u kq[8][2];
#pragma unroll
      for (int j = 0; j < 8; ++j) { const int kr = w0 + j; kq[j][0] = *(const GAS v4u*)(ksrc + (size_t)kr * 64 * NAI); kq[j][1] = *(const GAS v4u*)(ksrc + (size_t)kr * 64 * NAI + st_2nd); }
      __builtin_amdgcn_sched_barrier(0);
#pragma unroll
      for (int j = 0; j < 8; ++j) { const int sl = (w0 + j) & 7; *(LAS v4u*)(lds + NA_KR + sl * 8192 + st_dst) = kq[j][0]; *(LAS v4u*)(lds + NA_KR + sl * 8192 + st_dst2) = kq[j][1]; } }
    { v4u vq[8][2];
#pragma unroll
      for (int j = 0; j < 8; ++j) { const int kr = w0 + j; vq[j][0] = *(const GAS v4u*)(vsrc + (size_t)kr * 64 * NAI); vq[j][1] = *(const GAS v4u*)(vsrc + (size_t)kr * 64 * NAI + st_2nd); }
      __builtin_amdgcn_sched_barrier(0);
#pragma unroll
      for (int j = 0; j < 8; ++j) { const int sl = (w0 + j) & 7; *(LAS v4u*)(lds + NA_VR + sl * 8192 + st_dst) = vq[j][0]; *(LAS v4u*)(lds + NA_VR + sl * 8192 + st_dst2) = vq[j][1]; } }
    na_sync4(cnt, epoch, lane);
    const int reg0 = min(max(16 * seg - 8, 0), 32);
    const int qcol = 16 * seg + c16, win0 = min(max(qcol - 8, 0), 48);
    const int dcb = reg0 + 4 * g - qcol + 15, bsh = dcb & 3;
    const LAS unsigned char* bias_base = lds + NA_RPB + (bsh * 480 + (dcb - bsh)) * 4;
    unsigned vmask = 0u;
#pragma unroll
    for (int ct = 0; ct < 2; ++ct)
#pragma unroll
        for (int q = 0; q < 4; ++q) { const int kcol = reg0 + 16 * ct + 4 * g + q; if (kcol >= win0 && kcol < win0 + 16) vmask |= 1u << (4 * ct + q); }
    float mb4[4];
#pragma unroll
    for (int q = 0; q < 4; ++q) mb4[q] = p.mbias[h * 16 + 4 * g + q] * 1.4426950408889634f;
    int koff[2][2];
#pragma unroll
    for (int ct = 0; ct < 2; ++ct)
#pragma unroll
        for (int ks = 0; ks < 2; ++ks) { const int tok = reg0 + 16 * ct + c16; koff[ct][ks] = tok * 128 + (((g + 4 * ks) ^ ((tok >> 1) & 7)) << 4); }
    int voff[4][2];
#pragma unroll
    for (int e2 = 0; e2 < 4; ++e2)
#pragma unroll
        for (int hl = 0; hl < 2; ++hl) { const int tok = reg0 + 16 * hl + 4 * g + (c16 >> 2), ch = 2 * e2 + ((c16 & 3) >> 1); voff[e2][hl] = tok * 128 + ((ch ^ ((tok >> 1) & 7)) << 4) + 8 * (c16 & 1); }
    int vmoff[4];
#pragma unroll
    for (int e2 = 0; e2 < 4; ++e2) { const int tok = 4 * g + (c16 >> 2), ch = 2 * e2 + ((c16 & 3) >> 1); vmoff[e2] = tok * 128 + ((ch ^ ((tok >> 1) & 7)) << 4) + 8 * (c16 & 1); }
    const int kmoff0 = c16 * 128 + ((g ^ ((c16 >> 1) & 7)) << 4), kmoff1 = c16 * 128 + (((g + 4) ^ ((c16 >> 1) & 7)) << 4);
    bf16x8 qn_[2];
    { const bf16* qp = QN + ((size_t)b * LSEQ + NMETA + rfirst * 64 + qcol) * NAI + h * 64 + 8 * g; qn_[0] = *(const GAS bf16x8*)qp; qn_[1] = *(const GAS bf16x8*)(qp + 32); }
    for (int rr8 = 0; rr8 < 8; ++rr8) {
        const int r = rfirst + rr8, r0 = na_r0(r);
        const bool have_new = (rr8 < 7) && (na_r0(r + 1) != r0);
        const int newrow = r0 + 8;
        v4u nk = {0, 0, 0, 0}, nv = {0, 0, 0, 0}, nk2 = {0, 0, 0, 0}, nv2 = {0, 0, 0, 0};
        if (have_new) { nk = *(const GAS v4u*)(ksrc + (size_t)newrow * 64 * NAI); nv = *(const GAS v4u*)(vsrc + (size_t)newrow * 64 * NAI); nk2 = *(const GAS v4u*)(ksrc + (size_t)newrow * 64 * NAI + st_2nd); nv2 = *(const GAS v4u*)(vsrc + (size_t)newrow * 64 * NAI + st_2nd); }
        const bf16x8 qf[2] = {qn_[0], qn_[1]};
        if (rr8 < 7) { const bf16* qp = QN + ((size_t)b * LSEQ + NMETA + (r + 1) * 64 + qcol) * NAI + h * 64 + 8 * g; qn_[0] = *(const GAS bf16x8*)qp; qn_[1] = *(const GAS bf16x8*)(qp + 32); }
        f32x4 X[17];
        bf16x8 kfa[2][2][2], kfb[2][2][2];
        auto ldk = [&](bf16x8 (&kf)[2][2][2], int kp) {
#pragma unroll
            for (int k1 = 0; k1 < 2; ++k1) { const LAS unsigned char* ks_ = lds + NA_KR + ((r0 + 2 * kp + k1) & 7) * 8192;
#pragma unroll
                for (int ct = 0; ct < 2; ++ct) { kf[k1][ct][0] = *(const LAS bf16x8*)(ks_ + koff[ct][0]); kf[k1][ct][1] = *(const LAS bf16x8*)(ks_ + koff[ct][1]); } } };
        auto mmk = [&](const bf16x8 (&kf)[2][2][2], int kp) {
#pragma unroll
            for (int k1 = 0; k1 < 2; ++k1)
#pragma unroll
                for (int ct = 0; ct < 2; ++ct) { f32x4 x = __builtin_amdgcn_mfma_f32_16x16x32_bf16(kf[k1][ct][0], qf[0], (f32x4){0.f, 0.f, 0.f, 0.f}, 0, 0, 0);
                    X[2 * (2 * kp + k1) + ct] = __builtin_amdgcn_mfma_f32_16x16x32_bf16(kf[k1][ct][1], qf[1], x, 0, 0, 0); } };
        ldk(kfa, 0); __builtin_amdgcn_sched_barrier(0);
        ldk(kfb, 1); mmk(kfa, 0); __builtin_amdgcn_sched_barrier(0);
        ldk(kfa, 2); mmk(kfb, 1); __builtin_amdgcn_sched_barrier(0);
        ldk(kfb, 3); mmk(kfa, 2); __builtin_amdgcn_sched_barrier(0);
        const bf16x8 km0 = *(const LAS bf16x8*)(lds + NA_KM + kmoff0), km1 = *(const LAS bf16x8*)(lds + NA_KM + kmoff1);
        const LAS unsigned char* brow = bias_base + (r0 - r + 7) * 128;
        f32x4 bv16[16];
#pragma unroll
        for (int i = 0; i < 16; ++i) bv16[i] = *(const LAS f32x4*)(brow + (i >> 1) * 128 + (i & 1) * 64);
        s16x4 vla[2][4], vha[2][4], vlb[2][4], vhb[2][4];
        auto ldv = [&](s16x4 (&vl)[2][4], s16x4 (&vh)[2][4], int kp) {
#pragma unroll
            for (int k1 = 0; k1 < 2; ++k1) { const LAS unsigned char* vs_ = lds + NA_VR + ((r0 + 2 * kp + k1) & 7) * 8192;
#pragma unroll
                for (int e2 = 0; e2 < 4; ++e2) { vl[k1][e2] = ds_tr16(vs_ + voff[e2][0]); vh[k1][e2] = ds_tr16(vs_ + voff[e2][1]); } } };
        ldv(vla, vha, 0);
        mmk(kfb, 3);
        { f32x4 x = __builtin_amdgcn_mfma_f32_16x16x32_bf16(km0, qf[0], (f32x4){0.f, 0.f, 0.f, 0.f}, 0, 0, 0); X[16] = __builtin_amdgcn_mfma_f32_16x16x32_bf16(km1, qf[1], x, 0, 0, 0); }
        __builtin_amdgcn_sched_barrier(0);
        float mx = -INFINITY;
#pragma unroll
        for (int i = 0; i < 16; ++i) { const f32x4 bv = bv16[i];
#pragma unroll
            for (int q = 0; q < 4; ++q) { const float v = ((vmask >> (4 * (i & 1) + q)) & 1u) ? X[i][q] + bv[q] : -INFINITY; X[i][q] = v; mx = fmaxf(mx, v); } }
#pragma unroll
        for (int q = 0; q < 4; ++q) { const float v = X[16][q] + mb4[q]; X[16][q] = v; mx = fmaxf(mx, v); }
        mx = fmaxf(mx, __shfl_xor(mx, 16)); mx = fmaxf(mx, __shfl_xor(mx, 32));
        float sum = 0.f;
#pragma unroll
        for (int i = 0; i < 17; ++i)
#pragma unroll
            for (int q = 0; q < 4; ++q) { const float e = __builtin_amdgcn_exp2f(X[i][q] - mx); X[i][q] = e; sum += e; }
        sum += __shfl_xor(sum, 16); sum += __shfl_xor(sum, 32);
        const float inv = 1.0f / sum;
        f32x4 O[4] = {(f32x4){0.f, 0.f, 0.f, 0.f}, (f32x4){0.f, 0.f, 0.f, 0.f}, (f32x4){0.f, 0.f, 0.f, 0.f}, (f32x4){0.f, 0.f, 0.f, 0.f}};
        auto mmv = [&](const s16x4 (&vl)[2][4], const s16x4 (&vh)[2][4], int kp) {
#pragma unroll
            for (int k1 = 0; k1 < 2; ++k1) { const int kk = 2 * kp + k1; float pf[8];
#pragma unroll
                for (int j = 0; j < 4; ++j) { pf[j] = X[2 * kk][j]; pf[4 + j] = X[2 * kk + 1][j]; }
                const bf16x8 A = pack8(pf);
#pragma unroll
                for (int e2 = 0; e2 < 4; ++e2) O[e2] = __builtin_amdgcn_mfma_f32_16x16x32_bf16(cat8(vl[k1][e2], vh[k1][e2]), A, O[e2], 0, 0, 0); } };
        __builtin_amdgcn_sched_barrier(0);
        ldv(vlb, vhb, 1); mmv(vla, vha, 0); __builtin_amdgcn_sched_barrier(0);
        ldv(vla, vha, 2); mmv(vlb, vhb, 1); __builtin_amdgcn_sched_barrier(0);
        ldv(vlb, vhb, 3); mmv(vla, vha, 2); __builtin_amdgcn_sched_barrier(0);
        mmv(vlb, vhb, 3);
        { float pf[8];
#pragma unroll
          for (int j = 0; j < 4; ++j) { pf[j] = X[16][j]; pf[4 + j] = 0.f; }
          const bf16x8 A = pack8(pf);
#pragma unroll
          for (int e2 = 0; e2 < 4; ++e2) { const s16x4 lo = ds_tr16(lds + NA_VM + vmoff[e2]); const s16x4 z = {0, 0, 0, 0};
              O[e2] = __builtin_amdgcn_mfma_f32_16x16x32_bf16(cat8(lo, z), A, O[e2], 0, 0, 0); } }
        na_sync4(cnt, epoch, lane);
        if (have_new) { const int sl = newrow & 7; *(LAS v4u*)(lds + NA_KR + sl * 8192 + st_dst) = nk; *(LAS v4u*)(lds + NA_VR + sl * 8192 + st_dst) = nv;
            *(LAS v4u*)(lds + NA_KR + sl * 8192 + st_dst2) = nk2; *(LAS v4u*)(lds + NA_VR + sl * 8192 + st_dst2) = nv2; }
        na_sync4(cnt, epoch, lane);
        { bf16* op = YB + ((size_t)b * SEQ + r * 64 + qcol) * NAI + h * 64 + 4 * g;
#pragma unroll
          for (int e2 = 0; e2 < 4; ++e2) { v2u o; o.x = pg8::cvt_pk_safe(O[e2][0] * inv, O[e2][1] * inv); o.y = pg8::cvt_pk_safe(O[e2][2] * inv, O[e2][3] * inv); *(GAS v2u*)(op + 16 * e2) = o; } }
    }
}

__device__ __forceinline__ void p5_combine(const Ptrs& p, int gw, int NGW, int lane) {
    const bf16* XM = WSP(bf16, WS_XM); const bf16* SO = WSP(bf16, WS_SO); const bf16* HF = WSP(bf16, WS_HF); const bf16* HB = WSP(bf16, WS_HB); bf16* YA = WSP(bf16, WS_YA);
    float cw[3][16], cb[16]; load_conv_w(p, lane, cw, cb);
    float ng[16], sk[16];
#pragma unroll
    for (int q = 0; q < 4; ++q) { const f32x4 a = *(const GAS f32x4*)(p.mnorm_g + 16 * lane + 4 * q), s = *(const GAS f32x4*)(p.mskip + 16 * lane + 4 * q);
        ng[4 * q] = a.x; ng[4 * q + 1] = a.y; ng[4 * q + 2] = a.z; ng[4 * q + 3] = a.w; sk[4 * q] = s.x; sk[4 * q + 1] = s.y; sk[4 * q + 2] = s.z; sk[4 * q + 3] = s.w; }
    for (int tok = gw; tok < MTOK; tok += NGW) {
        const int b = tok >> 12, s = tok & 4095, l = s + NMETA;
        const size_t to = (size_t)tok * 1024 + 16 * lane, ro = ((size_t)b * LSEQ + l) * 1024 + 16 * lane;
        const v4u f0 = *(const GAS v4u*)(HF + to), f1 = *(const GAS v4u*)(HF + to + 8), b0 = *(const GAS v4u*)(HB + to), b1 = *(const GAS v4u*)(HB + to + 8);
        const v4u o0 = *(const GAS v4u*)(SO + ro), o1 = *(const GAS v4u*)(SO + ro + 8);
        float xc[16]; conv_silu16(XM, b, l, lane, cw, cb, xc);
        float hs[16]; float ss = 0.f;
#pragma unroll
        for (int e = 0; e < 4; ++e) { hs[2 * e] = bflo(f0[e]) + bflo(b0[e]); hs[2 * e + 1] = bfhi(f0[e]) + bfhi(b0[e]); hs[8 + 2 * e] = bflo(f1[e]) + bflo(b1[e]); hs[8 + 2 * e + 1] = bfhi(f1[e]) + bfhi(b1[e]); }
#pragma unroll
        for (int j = 0; j < 16; ++j) ss += hs[j] * hs[j];
        ss += __shfl_xor(ss, 1); ss += __shfl_xor(ss, 2); ss += __shfl_xor(ss, 4); ss += __shfl_xor(ss, 8);
        const float rs = 1.0f / sqrtf(ss * (1.f / 256.f) + EPS);
        float so[16];
#pragma unroll
        for (int e = 0; e < 4; ++e) { so[2 * e] = bflo(o0[e]); so[2 * e + 1] = bfhi(o0[e]); so[8 + 2 * e] = bflo(o1[e]); so[8 + 2 * e + 1] = bfhi(o1[e]); }
        float y[16];
#pragma unroll
        for (int j = 0; j < 16; ++j) y[j] = so[j] * (hs[j] * rs * ng[j] + sk[j] * xc[j]);
        v4u w0, w1; w0.x = pk2(y[0], y[1]); w0.y = pk2(y[2], y[3]); w0.z = pk2(y[4], y[5]); w0.w = pk2(y[6], y[7]); w1.x = pk2(y[8], y[9]); w1.y = pk2(y[10], y[11]); w1.z = pk2(y[12], y[13]); w1.w = pk2(y[14], y[15]);
        bf16* yo = YA + (size_t)(lane >> 5) * MTOK * 512 + (size_t)tok * 512 + 16 * (lane & 31);
        *(GAS v4u*)yo = w0; *(GAS v4u*)(yo + 8) = w1;
    }
}

constexpr int NPHASE = 10;
struct Args { Ptrs p; int ph_lo, ph_hi, li, flags; };
__global__ void __launch_bounds__(NTHR, 2) fwd_megakernel(Args args) {
    extern __shared__ __attribute__((aligned(16))) unsigned char lds_raw[];
    LAS unsigned char* lds = (LAS unsigned char*)lds_raw;
    const Ptrs& p = args.p;
    const int G = gridDim.x, bx = blockIdx.x;
    const int vcu = (G % 8 == 0) ? (bx % 8) * (G / 8) + bx / 8 : bx;
    const int NGW = G * NWAVES;
#define IDS() int tid = threadIdx.x; asm volatile("" : "+v"(tid)); const int lane = tid & 63, wave = __builtin_amdgcn_readfirstlane(tid >> 6), gw = vcu * NWAVES + wave; (void)lane; (void)gw
    for (int u = threadIdx.x; u < (LDS_BYTES - LDSCTL_OFF) / 4; u += NTHR) ((LAS unsigned*)(lds + LDSCTL_OFF))[u] = 0u;
    __syncthreads();
    const XcdBarrier bar = xcd_barrier_post((unsigned*)(p.ws + WS_CTL) + CW_BAR + args.li * XCD_BAR_WORDS, (volatile LAS unsigned*)(lds + MISC_OFF) + 8);
    const int lo = args.ph_lo, hi = args.ph_hi;
#define IN(k) (lo <= (k) && (k) < hi)
#define SEAM(k) do { if (IN(k) && IN((k) + 1)) xcd_barrier(bar); } while (0)
#define SEAM2(k, blk) do { if (IN(k) && IN((k) + 1)) { unsigned* const w_ = (unsigned*)(p.ws + WS_CTL) + 16384 + 1088 * (blk); sb_arrive(bar, w_); if (threadIdx.x == 0) sb_wait_lane0(bar, w_); __syncthreads(); } } while (0)

#ifdef MK_XBAR
    for (int i = 0; i < MK_XBAR; ++i) xcd_barrier(bar);
#endif
    unsigned* const sbw01 = (unsigned*)(p.ws + WS_CTL);
    if (IN(0)) { IDS(); p0_prologue<0>(p, lds, gw, NGW, wave, lane);
        if (IN(1)) sb_arrive(bar, sbw01);
        p0_prologue<1>(p, lds, gw, NGW, wave, lane);
        if (IN(1)) { if (threadIdx.x == 0) sb_wait_lane0(bar, sbw01); __syncthreads(); } }

    if (IN(1)) {
        pg8::Gemm g{WSP(bf16, WS_XN), WSP(bf16, WS_WIN), 1024, 1024, 1024, 0, nullptr, nullptr, 1 << 20}; pg8::StaticOrder S; S.init(RP, NIN, G, bx);
        EpiIn E{p.ws, p.out, p.qn_g, p.kn_g};
        pg8::gemm_phase<EpiIn, pg8::StaticOrder, true, true>(lds, g, S, E);
    } SEAM2(1, 1);


    if (IN(3)) {
        { IDS(); pg8::StaticOrder S0; S0.init(MTOK, 1024, G, bx); pg8::Unit u0; if (!S0.next(0, u0)) { u0.pm = 0; u0.pn = 0; }
          p3_head(p, lds, u0.pm, u0.pn, vcu, gw, NGW, wave, lane); }
        { pg8::Gemm g{WSP(bf16, WS_XC), WSP(bf16, WS_WQK), 256, 1024, 256, 256, nullptr, nullptr, 1 << 20}; pg8::StaticOrder S; S.init(MTOK, 1024, G, bx);
          EpiStoreBf16 E{WSP(bf16, WS_QKM), 1024};
          pg8::gemm_phase<EpiStoreBf16, pg8::StaticOrder, true, true>(lds, g, S, E); }
    } SEAM2(3, 2);

    if (IN(4)) {
        IDS();
        __syncthreads();
        scan_setup(p, lds, vcu, wave, lane);
        scan_prepass(p, lds, vcu, wave, lane);
        { unsigned* const w_ = (unsigned*)(p.ws + WS_CTL) + 16384 + 1088 * 3; sb_arrive(bar, w_); scan_zero_images(lds, tid); if (threadIdx.x == 0) sb_wait_lane0(bar, w_); __syncthreads(); }
        if (!(args.flags & 2)) scan_item(p, lds, vcu, tid, wave, lane, args.flags);
    }
    unsigned* const sbw45 = (unsigned*)(p.ws + WS_CTL) + 2240;
    if (IN(4) && IN(5)) sb_arrive(bar, sbw45);

    if (IN(5)) {
        IDS(); __syncthreads();
        const int role_idx = (wave & 1) + 2 * (wave >> 2);
        if (!(wave & 2)) { if (!(args.flags & 4)) na_block4(p, lds, vcu, role_idx * 64 + lane, role_idx, lane); }
        else {
            if (IN(4)) {
                LAS unsigned* flag = (LAS unsigned*)(lds + MISC_OFF + 96);
                if (wave == 2) { if (lane == 0) { sb_wait_lane0(bar, sbw45); __hip_atomic_store(flag, 1u, __ATOMIC_RELAXED, __HIP_MEMORY_SCOPE_WORKGROUP); } }
                unsigned sp = 0;
                while ((unsigned)__builtin_amdgcn_readfirstlane((int)__hip_atomic_load(flag, __ATOMIC_RELAXED, __HIP_MEMORY_SCOPE_WORKGROUP)) == 0u) { __builtin_amdgcn_s_sleep(1); if (++sp > (1u << 24)) break; }
                asm volatile("" ::: "memory");
            }
            p5_combine(p, vcu * 4 + role_idx, G * 4, lane);
        }
    } SEAM2(5, 4);

    if (IN(6)) {
        pg8::Gemm g{WSP(bf16, WS_YA), WSP(bf16, WS_WA), 1536, 512, 1536, 0, WSP(bf16, WS_YA) + (size_t)MTOK * 512, WSP(bf16, WS_YB), 8}; pg8::StaticOrder S; S.init(MTOK, 1024, G, bx);
        EpiMix E{WSP(bf16, WS_MIX), (const bf16*)p.out, (const bf16*)p.out + (size_t)MTOK * 1024};
        pg8::gemm_phase<EpiMix, pg8::StaticOrder, true, true>(lds, g, S, E);
    }
    unsigned* const sbw67 = (unsigned*)(p.ws + WS_CTL) + 1088;
    if (IN(6) && IN(7)) sb_arrive(bar, sbw67);

    if (IN(7)) {
        { IDS(); p_ffw<0>(p, lds, gw, NGW, wave, lane); }
        if (IN(6)) { if (threadIdx.x == 0) sb_wait_lane0(bar, sbw67); }
        __syncthreads();
        pg8::Gemm g{WSP(bf16, WS_MIX), WSP(bf16, WS_WOUT), 1024, 1024, 1024, 0, nullptr, nullptr, 1 << 20}; pg8::StaticOrder S; S.init(MTOK, 1024, G, bx);
        EpiOut E{p.x, p.out, WSP(bf16, WS_H2B), WSP(float, WS_ROWSS)};
        pg8::gemm_phase<EpiOut, pg8::StaticOrder, true, true>(lds, g, S, E);
    }
    unsigned* const sbw78 = (unsigned*)(p.ws + WS_CTL) + 16384;
    if (IN(7) && IN(8)) sb_arrive(bar, sbw78);

    if (IN(8)) {
        { IDS(); p_ffw<1>(p, lds, gw, NGW, wave, lane); }
        if (IN(7)) { if (threadIdx.x == 0) sb_wait_lane0(bar, sbw78); }
        __syncthreads();
        pg8::Gemm g{WSP(bf16, WS_H2B), WSP(bf16, WS_WFF1), 1024, 1024, 1024, 0, nullptr, nullptr, 1 << 20}; pg8::StaticOrder S; S.init(MTOK, DFF, G, bx);
        EpiFF1 E{WSP(bf16, WS_HID), WSP(float, WS_ROWSS)};
        pg8::gemm_phase<EpiFF1, pg8::StaticOrder, true, true>(lds, g, S, E);
    } SEAM2(8, 5);

    if (IN(9)) {
        pg8::Gemm g{WSP(bf16, WS_HID), WSP(bf16, WS_WFF2), 4096, 4096, 4096, 0, nullptr, nullptr, 1 << 20}; pg8::StaticOrder S; S.init(MTOK, 1024, G, bx);
        EpiFF2 E{p.out, WSP(bf16, WS_H2B)};
        pg8::gemm_phase<EpiFF2, pg8::StaticOrder, true, true>(lds, g, S, E);
    }
#undef IN
#undef SEAM
}

extern "C" void kernel_launch(void* const* d_in, const int* in_sizes, int n_in, void* d_out, int out_size, void* d_ws, size_t ws_size, hipStream_t stream) {
    static int grid = 0;
    if (grid == 0) {
        if (n_in != 21 || in_sizes[0] != MTOK * DM || out_size != MTOK * DM || ws_size < WS_END) { fprintf(stderr, "kernel_launch: unexpected shapes (n_in %d, in0 %d, out %d, ws %zu); nothing launched\n", n_in, n_in > 0 ? in_sizes[0] : -1, out_size, ws_size); grid = -1; return; }
        int dev = 0, cus = 0, per_cu = 0;
        if (hipGetDevice(&dev) != hipSuccess || hipDeviceGetAttribute(&cus, hipDeviceAttributeMultiprocessorCount, dev) != hipSuccess) { grid = -1; return; }
        if (hipFuncSetAttribute((const void*)fwd_megakernel, hipFuncAttributeMaxDynamicSharedMemorySize, LDS_BYTES) != hipSuccess) { fprintf(stderr, "kernel_launch: hipFuncSetAttribute failed\n"); grid = -1; return; }
        if (hipOccupancyMaxActiveBlocksPerMultiprocessor(&per_cu, (const void*)fwd_megakernel, NTHR, LDS_BYTES) != hipSuccess || per_cu < 1) { fprintf(stderr, "kernel_launch: occupancy query reports %d workgroups per CU\n", per_cu); per_cu = 1; }
        (void)hipGetLastError();
        grid = cus;
    }
    if (grid < 0) return;
    if (hipMemsetAsync((char*)d_ws + WS_CTL, 0, CTL_ZERO_BYTES, stream) != hipSuccess) return;
    Args a{};
    const float** pp = (const float**)&a.p;
    for (int i = 0; i < 21; ++i) pp[i] = (const float*)d_in[i];
    a.p.out = (float*)d_out; a.p.ws = (unsigned char*)d_ws;
#ifndef MK_SUBFLAGS
#define MK_SUBFLAGS 0
#endif
#if defined(MK_DUP)
#ifndef MK_DUP_END
#define MK_DUP_END (MK_DUP + 1)
#endif
    const int cuts[4][2] = {{0, MK_DUP_END}, {MK_DUP, MK_DUP_END}, {MK_DUP_END, NPHASE}, {0, 0}};
    for (int li = 0; li < 3; ++li) { if (cuts[li][0] >= cuts[li][1]) continue; a.ph_lo = cuts[li][0]; a.ph_hi = cuts[li][1]; a.li = li; a.flags = (li == 1) ? (1 | MK_SUBFLAGS) : 0;
        hipLaunchKernelGGL(fwd_megakernel, dim3(grid), dim3(NTHR), LDS_BYTES, stream, a); }
#else
    a.ph_lo = 0; a.ph_hi = NPHASE; a.li = 0; a.flags = 0;
    hipLaunchKernelGGL(fwd_megakernel, dim3(grid), dim3(NTHR), LDS_BYTES, stream, a);
#endif
}
```

```cpp
#include <hip/hip_runtime.h>
#include <cstdio>
#include <cstdint>

namespace pg8 {
#define PG8_LAS __attribute__((address_space(3)))
typedef unsigned short bf16_t;
typedef short bf16x8 __attribute__((ext_vector_type(8)));
typedef float f32x4 __attribute__((ext_vector_type(4)));
typedef unsigned u32x4 __attribute__((ext_vector_type(4)));
typedef unsigned u32x2 __attribute__((ext_vector_type(2)));
typedef PG8_LAS float PG8_LAS_F;
constexpr int BM = 256, BK = 64, HALF = 128, HTB = HALF * BK * 2  , STAGE_BYTES = 8 * HTB, NXCD = 8, WGM = 8;

__host__ __device__ __forceinline__ int lds_byte(int r, int c) { const int st = (r >> 4) * 2 + (c >> 5), rr = r & 15, cc = c & 31, ob = rr * 64 + cc * 2; return st * 1024 + (ob ^ (((ob >> 9) & 1) << 5)); }
__host__ __device__ __forceinline__ void stage_rc(int b, int& R, int& C) { const int st = b / 1024, sb = b % 1024, swz = sb ^ (((sb >> 9) & 1) << 5); R = (st >> 1) * 16 + swz / 64; C = (st & 1) * 32 + (swz % 64) / 2; }
__host__ __device__ __forceinline__ int perm32(int rho) { const int n = rho >> 4, i = rho & 15; return 8 * (i >> 2) + 4 * n + (i & 3); }

struct Unit { int pm, pn, idx; };
struct Gemm { const bf16_t* A; const bf16_t* Bt; int K, lda, ldb, a_pn_cols; const bf16_t* A1; const bf16_t* A2; int plane_tiles; };

struct StaticOrder {
    int nM, nN, nwg, G, c;
    __host__ __device__ void init(int M, int N, int G_, int c_) { nM = M / BM; nN = N / BM; nwg = nM * nN; G = G_; c = c_; }
    __host__ __device__ bool next(int i, Unit& u) const {
        const long L = (long)i * G + c; if (L >= nwg) return false;
        int wgid = (int)L; { const int q = nwg / NXCD, r = nwg % NXCD, xcd = wgid % NXCD, off = wgid / NXCD; wgid = (xcd < r ? xcd * (q + 1) : r * (q + 1) + (xcd - r) * q) + off; }
        const int nig = WGM * nN, gid = wgid / nig, fm = gid * WGM, gsz = (nM - fm) < WGM ? (nM - fm) : WGM;
        u.pm = fm + ((wgid % nig) % gsz); u.pn = (wgid % nig) / gsz; return true;
    }
};

typedef float f32x2_t __attribute__((ext_vector_type(2))); typedef __bf16 bf16x2_t __attribute__((ext_vector_type(2)));
__device__ __forceinline__ unsigned cvt_pk_safe(float lo, float hi) { f32x2_t v = {lo, hi}; bf16x2_t b = __builtin_convertvector(v, bf16x2_t); return __builtin_bit_cast(unsigned, b); }
__device__ __forceinline__ unsigned cvt_pk_bf16(float lo, float hi) { unsigned r; asm volatile("v_cvt_pk_bf16_f32 %0, %1, %2" : "=v"(r) : "v"(lo), "v"(hi)); return r; }

template <class Epi, class Sched, bool ALIGN_EPI = false, bool SP2 = false>
__device__ __forceinline__ void gemm_phase(PG8_LAS unsigned char* lds, const Gemm g, const Sched& S, const Epi& E) {
    const int tid = threadIdx.x, wid = __builtin_amdgcn_readfirstlane(tid >> 6), lane = tid & 63, wr = wid >> 2, wc = wid & 3, fr = lane & 15, fq = lane >> 4;
    const int K = g.K, nt = K / BK;
    unsigned voffA[2], voffB[2];
    constexpr bool WCOLS = Epi::WCOLS;
#pragma unroll
    for (int i = 0; i < 2; ++i) { int R, C; stage_rc(tid * 16 + i * 8192, R, C); const int Rb = Epi::PERM ? (WCOLS ? (64 * (R >> 5) + perm32(R & 31)) : ((R & ~31) + perm32(R & 31))) : R;
        voffA[i] = (unsigned)(R * g.lda + C) * 2u; voffB[i] = (unsigned)(Rb * g.ldb + C) * 2u; }
    const size_t kstep = (size_t)(BK * 2);
    const size_t hstepA = (size_t)HALF * g.lda * 2, hstepB = (size_t)(WCOLS ? 32 : HALF) * g.ldb * 2;
    const size_t tstepA = 2 * hstepA, tstepB = (size_t)BM * g.ldb * 2;
    const size_t pnA = (size_t)g.a_pn_cols * 2;
    const unsigned ldsw = (unsigned)wid * 1024u;
    const int aoff = lds_byte(wr * 64 + fr, fq * 8), boff = lds_byte(wc * 32 + fr, fq * 8);
#define PG8_SA(b, h) (((b) * 2 + (h)) * HTB)
#define PG8_SB(b, h) ((4 + (b) * 2 + (h)) * HTB)
#define PG8_STAGE(bufoff, gbase, voff) do { _Pragma("unroll") for (int _i = 0; _i < 2; ++_i) \
        __builtin_amdgcn_global_load_lds((const unsigned*)((const char*)(gbase) + (voff)[_i]), (PG8_LAS unsigned*)(lds + (bufoff) + ldsw + _i * 8192), 16, 0, 0); } while (0)
#define PG8_LDA(dst, b, h) do { _Pragma("unroll") for (int m = 0; m < 4; ++m) _Pragma("unroll") for (int k = 0; k < 2; ++k) dst[m][k] = *(const PG8_LAS bf16x8*)(lds + PG8_SA(b, h) + aoff + m * 2048 + k * 1024); } while (0)
#define PG8_LDB(dst, b, h) do { _Pragma("unroll") for (int n = 0; n < 2; ++n) _Pragma("unroll") for (int k = 0; k < 2; ++k) dst[n][k] = *(const PG8_LAS bf16x8*)(lds + PG8_SB(b, h) + boff + n * 2048 + k * 1024); } while (0)
#define PG8_MMA(ai, bj, At, Bt) do { __builtin_amdgcn_s_setprio(1); _Pragma("unroll") for (int m = 0; m < 4; ++m) _Pragma("unroll") for (int n = 0; n < 2; ++n) _Pragma("unroll") for (int k = 0; k < 2; ++k) \
        acc[ai][bj][m][n] = __builtin_amdgcn_mfma_f32_16x16x32_bf16(Bt[n][k], At[m][k], acc[ai][bj][m][n], 0, 0, 0); __builtin_amdgcn_s_setprio(0); } while (0)
#define PG8_WAIT_V(n) asm volatile("s_waitcnt vmcnt(" #n ")" ::: "memory")
#define PG8_WAIT_L(n) asm volatile("s_waitcnt lgkmcnt(" #n ")" ::: "memory")
#define PG8_BAR __builtin_amdgcn_s_barrier()
#define PG8_SCHED __builtin_amdgcn_sched_barrier(0)
    Unit cur, nxt; int ui = 0;
    if (!S.next(0, cur)) return;
    f32x4 acc[2][2][4][2];
#pragma unroll
    for (int a = 0; a < 2; ++a)
#pragma unroll
        for (int b = 0; b < 2; ++b)
#pragma unroll
            for (int m = 0; m < 4; ++m)
#pragma unroll
                for (int n = 0; n < 2; ++n) acc[a][b][m][n] = (f32x4){0.f, 0.f, 0.f, 0.f};
    bf16x8 At[4][2], B0[2][2], B1[2][2];
    const int pt = g.plane_tiles; const long long pj1 = (const char*)g.A1 - (const char*)g.A - (long long)pt * (long long)kstep, pj2 = (const char*)g.A2 - (const char*)g.A - 2ll * pt * (long long)kstep;
#define PG8_AT(base, t) ((base) + (size_t)(t) * kstep + (((t) >= pt) ? (((t) >= 2 * pt) ? pj2 : pj1) : 0ll))
    const char* cA = (const char*)g.A + (size_t)cur.pm * tstepA + (size_t)cur.pn * pnA; const char* cB = (const char*)g.Bt + (size_t)cur.pn * tstepB;
    if constexpr (SP2) {
        PG8_STAGE(PG8_SB(0, 0), cB, voffB); PG8_STAGE(PG8_SB(0, 1), cB + hstepB, voffB); PG8_STAGE(PG8_SA(0, 0), cA, voffA); PG8_STAGE(PG8_SA(0, 1), cA + hstepA, voffA);
        if (wr == 1) PG8_BAR;
        PG8_WAIT_V(2); PG8_BAR;
        PG8_STAGE(PG8_SB(1, 0), cB + kstep, voffB); PG8_STAGE(PG8_SA(1, 0), cA + kstep, voffA); PG8_STAGE(PG8_SB(1, 1), cB + hstepB + kstep, voffB);
        PG8_WAIT_V(6); PG8_BAR;
    } else {
        PG8_STAGE(PG8_SB(0, 0), cB, voffB); PG8_STAGE(PG8_SA(0, 0), cA, voffA); PG8_STAGE(PG8_SB(0, 1), cB + hstepB, voffB); PG8_STAGE(PG8_SA(0, 1), cA + hstepA, voffA);
        if (wr == 1) PG8_BAR;
        PG8_WAIT_V(4); PG8_BAR;
        PG8_STAGE(PG8_SB(1, 0), cB + kstep, voffB); PG8_STAGE(PG8_SA(1, 0), cA + kstep, voffA); PG8_STAGE(PG8_SB(1, 1), cB + hstepB + kstep, voffB);
        PG8_WAIT_V(6); PG8_BAR;
    }
    for (;;) {
        const bool has_next = S.next(ui + 1, nxt);
        const char* nA = has_next ? (const char*)g.A + (size_t)nxt.pm * tstepA + (size_t)nxt.pn * pnA : cA; const char* nB = has_next ? (const char*)g.Bt + (size_t)nxt.pn * tstepB : cB;
        for (int t = 0; t < nt; t += 2) {
            const bool last = (t == nt - 2);
            if constexpr (Epi::MID_T >= 0) { if (t == Epi::MID_T) E.mid(acc, cur, wr, wc, fr, fq); }
            const char* a1 = PG8_AT(cA, t + 1);
            const char* a2 = last ? nA : PG8_AT(cA, t + 2); const char* b2 = last ? nB : cB + (size_t)(t + 2) * kstep;
            const char* a3 = a2 + kstep; const char* b3 = b2 + kstep;
            if constexpr (SP2) {
            PG8_LDB(B0, 0, 0); PG8_LDB(B1, 0, 1); PG8_SCHED; PG8_LDA(At, 0, 0); PG8_STAGE(PG8_SA(1, 1), a1 + hstepA, voffA);
            PG8_WAIT_V(8); PG8_WAIT_L(0); PG8_BAR; PG8_MMA(0, 0, At, B0); PG8_MMA(0, 1, At, B1); PG8_BAR; PG8_SCHED;
            PG8_LDA(At, 0, 1); PG8_STAGE(PG8_SB(0, 0), b2, voffB); PG8_STAGE(PG8_SB(0, 1), b2 + hstepB, voffB); PG8_STAGE(PG8_SA(0, 0), a2, voffA);
            PG8_WAIT_V(8); PG8_WAIT_L(0); PG8_BAR; PG8_MMA(1, 0, At, B0); PG8_MMA(1, 1, At, B1); PG8_BAR; PG8_SCHED;
            PG8_LDB(B0, 1, 0); PG8_LDB(B1, 1, 1); PG8_SCHED; PG8_LDA(At, 1, 0); PG8_STAGE(PG8_SA(0, 1), a2 + hstepA, voffA);
            PG8_WAIT_V(8); PG8_WAIT_L(0); PG8_BAR; PG8_MMA(0, 0, At, B0); PG8_MMA(0, 1, At, B1); PG8_BAR; PG8_SCHED;
            PG8_LDA(At, 1, 1); PG8_STAGE(PG8_SB(1, 0), b3, voffB); PG8_STAGE(PG8_SB(1, 1), b3 + hstepB, voffB); PG8_STAGE(PG8_SA(1, 0), a3, voffA);
            PG8_WAIT_V(8); PG8_WAIT_L(0); PG8_BAR; PG8_MMA(1, 0, At, B0); PG8_MMA(1, 1, At, B1); PG8_BAR; PG8_SCHED;
            } else {
            PG8_LDB(B0, 0, 0); PG8_SCHED; PG8_LDA(At, 0, 0); PG8_STAGE(PG8_SA(1, 1), a1 + hstepA, voffA);
            PG8_WAIT_L(8); PG8_BAR; PG8_WAIT_L(0); PG8_MMA(0, 0, At, B0); PG8_BAR; PG8_SCHED;
            PG8_LDB(B1, 0, 1); PG8_STAGE(PG8_SB(0, 0), b2, voffB);
            PG8_BAR; PG8_WAIT_L(0); PG8_MMA(0, 1, At, B1); PG8_BAR;
            PG8_LDA(At, 0, 1); PG8_STAGE(PG8_SA(0, 0), a2, voffA);
            PG8_BAR; PG8_WAIT_L(0); PG8_MMA(1, 0, At, B0); PG8_BAR; PG8_SCHED;
            PG8_STAGE(PG8_SB(0, 1), b2 + hstepB, voffB);
            PG8_WAIT_V(6); PG8_BAR; PG8_MMA(1, 1, At, B1); PG8_BAR;
            PG8_LDB(B0, 1, 0); PG8_SCHED; PG8_LDA(At, 1, 0); PG8_STAGE(PG8_SA(0, 1), a2 + hstepA, voffA);
            PG8_WAIT_L(8); PG8_BAR; PG8_WAIT_L(0); PG8_MMA(0, 0, At, B0); PG8_BAR; PG8_SCHED;
            PG8_LDB(B1, 1, 1); PG8_STAGE(PG8_SB(1, 0), b3, voffB);
            PG8_BAR; PG8_WAIT_L(0); PG8_MMA(0, 1, At, B1); PG8_BAR;
            PG8_LDA(At, 1, 1); PG8_STAGE(PG8_SA(1, 0), a3, voffA);
            PG8_BAR; PG8_WAIT_L(0); PG8_MMA(1, 0, At, B0); PG8_BAR; PG8_SCHED;
            PG8_STAGE(PG8_SB(1, 1), b3 + hstepB, voffB);
            PG8_WAIT_V(6); PG8_BAR; PG8_MMA(1, 1, At, B1); PG8_BAR;
            }
        }
        if constexpr (ALIGN_EPI) { if (wr == 0) PG8_BAR; }
        { int t2 = threadIdx.x; asm volatile("" : "+v"(t2)); const int l2 = t2 & 63;
          cur.idx = ui;
          E(acc, cur, wr, wc, l2 & 15, l2 >> 4); }
        if (!has_next) break;
#pragma unroll
        for (int a = 0; a < 2; ++a)
#pragma unroll
            for (int b = 0; b < 2; ++b)
#pragma unroll
                for (int m = 0; m < 4; ++m)
#pragma unroll
                    for (int n = 0; n < 2; ++n) acc[a][b][m][n] = (f32x4){0.f, 0.f, 0.f, 0.f};
        cur = nxt; cA = nA; cB = nB; ++ui;
        if constexpr (ALIGN_EPI) { if (wr == 1) PG8_BAR; }
    }
    PG8_WAIT_V(0);
    if constexpr (!ALIGN_EPI) { if (wr == 0) PG8_BAR; }
    PG8_BAR;
#undef PG8_AT
#undef PG8_SA
#undef PG8_SB
#undef PG8_STAGE
#undef PG8_LDA
#undef PG8_LDB
#undef PG8_MMA
#undef PG8_WAIT_V
#undef PG8_WAIT_L
#undef PG8_BAR
#undef PG8_SCHED
}
}

constexpr int NWAVES = 8, NTHR = 512;
constexpr int BATCH = 4, SEQ = 4096, DM = 1024, NMETA = 16, LSEQ = SEQ + NMETA;
constexpr int RV = BATCH * LSEQ;
constexpr int RP = 16640;
constexpr int MTOK = BATCH * SEQ;
constexpr int NIN = 5888;
constexpr int MH = 4, MDV = 256, MDK = 128, NAH = 8, NADH = 64, NAI = 512, DFF = 4096;
constexpr int HIDP = DFF + 64;
constexpr int NCHUNK = 65;
constexpr float EPS = 1e-6f;

constexpr size_t MiB = 1u << 20, QMiB = 1u << 18;
constexpr size_t WS_CTL = 0, CTL_ZERO_BYTES = 128 * 1024;
constexpr size_t WS_WIN = 3 * MiB;
constexpr size_t WS_WQK = 58 * QMiB;
constexpr size_t WS_WA = 15 * MiB;
constexpr size_t WS_WB = 17 * MiB;
constexpr size_t WS_WOUT = 18 * MiB;
constexpr size_t WS_RA = 20 * MiB;
constexpr size_t WS_VR = WS_RA, WS_WFF1 = WS_RA, WS_WFF2 = WS_RA + 8 * MiB;
constexpr size_t WS_SFRAG = 3 * MiB;
constexpr size_t WS_RB = 145 * QMiB;
constexpr size_t WS_XM = WS_RB, WS_H2B = WS_RB;
constexpr size_t WS_RC = 275 * QMiB;
constexpr size_t WS_SO = WS_RC, WS_MIX = WS_RC;
constexpr size_t WS_QN = 405 * QMiB;
constexpr size_t WS_KN = 470 * QMiB;
constexpr size_t WS_YB = 535 * QMiB;
constexpr size_t WS_FAC = WS_YB;
constexpr size_t WS_YA = 730 * QMiB;
constexpr size_t WS_RG = 150 * MiB;
constexpr size_t WS_XN = WS_RG, WS_XC = WS_RG, WS_HF = WS_RG;
constexpr size_t WS_QKM = 730 * QMiB;
constexpr size_t WS_HB = 215 * MiB;
constexpr size_t WS_GATES = 247 * MiB;
constexpr size_t WS_SCAL = 994 * QMiB;
constexpr size_t WS_ROWSS = 1002 * QMiB;
constexpr size_t WS_HID = WS_QN;
constexpr size_t WS_END = 256 * MiB;
constexpr size_t SCAL_ARR = (size_t)32 * NCHUNK * 64;
static_assert(WS_SFRAG + (size_t)32 * 64 * 6 * 1024 <= WS_WA && WS_GATES + (size_t)RP * 16 * 4 <= WS_SCAL && WS_SCAL + 3 * SCAL_ARR * 4 <= WS_ROWSS && WS_ROWSS + (size_t)MTOK * 16 * 4 <= WS_END, "small buffers");
static_assert(WS_YB + (size_t)MTOK * 512 * 2 <= WS_RG && WS_HID + (size_t)MTOK * HIDP * 2 <= WS_GATES && WS_H2B + (size_t)MTOK * DM * 2 <= WS_RC, "ws map");
constexpr int CW_BAR = 4096;

constexpr int RING_BYTES = 131072;
constexpr int LDSCTL_OFF = 146944, MISC_OFF = LDSCTL_OFF + 320;
constexpr int LDS_BYTES = 147456;

#define GAS __attribute__((address_space(1)))
#define LAS __attribute__((address_space(3)))
typedef unsigned short bf16;
typedef unsigned v4u __attribute__((ext_vector_type(4)));
typedef unsigned v2u __attribute__((ext_vector_type(2)));
typedef float f32x4 __attribute__((ext_vector_type(4)));
typedef short bf16x8 __attribute__((ext_vector_type(8)));
typedef short s16x4 __attribute__((ext_vector_type(4)));
typedef GAS unsigned gu32;
#define RLX_AGENT __ATOMIC_RELAXED, __HIP_MEMORY_SCOPE_AGENT
#define LDS_WAIT() asm volatile("s_waitcnt lgkmcnt(0)" ::: "memory")
__device__ __forceinline__ unsigned f2bf(float f) { unsigned u = __builtin_bit_cast(unsigned, f); return (u + 0x7fffu + ((u >> 16) & 1u)) >> 16; }
__device__ __forceinline__ unsigned pk2(float lo, float hi) { return f2bf(lo) | (f2bf(hi) << 16); }
__device__ __forceinline__ float bflo(unsigned u) { return __builtin_bit_cast(float, u << 16); }
__device__ __forceinline__ float bfhi(unsigned u) { return __builtin_bit_cast(float, u & 0xffff0000u); }
__device__ __forceinline__ float bf1(unsigned short u) { return __builtin_bit_cast(float, (unsigned)u << 16); }
__device__ __forceinline__ float sigmoidf_(float x) { return __builtin_amdgcn_rcpf(1.0f + __expf(-x)); }

#define XB_TMO      128
#define XB_XCNT(j)  (256  + 64 * (j))
#define XB_XSUB(j)  (1280 + 64 * (j))
#define XB_XGEN(j)  (2304 + 64 * (j))
#define XB_TOP      3328
#define XB_TOPGEN   3392
#define XCD_BAR_WORDS 3456
#define XB_SPIN_CAP (1u << 22)

__device__ __forceinline__ unsigned xb_ld(unsigned* p)              { return __hip_atomic_load(p, __ATOMIC_RELAXED, __HIP_MEMORY_SCOPE_AGENT); }
__device__ __forceinline__ unsigned xb_add(unsigned* p, unsigned v) { return __hip_atomic_fetch_add(p, v, __ATOMIC_RELAXED, __HIP_MEMORY_SCOPE_AGENT); }
__device__ __forceinline__ unsigned xb_xcc_id() { return (unsigned)__builtin_amdgcn_s_getreg((3 << 11) | 20) & 0xFu; }
#define XB_SPIN(cond, bar) do { unsigned _sp = 0; while (cond) { __builtin_amdgcn_s_sleep(1); \
    if ((++_sp & 255u) == 0u) { if (xb_ld(&(bar)[XB_TMO])) break; if (_sp > XB_SPIN_CAP) { atomicAdd(&(bar)[XB_TMO], 1u); break; } } } } while (0)

struct XcdBarrier { unsigned* bar; unsigned x; volatile LAS unsigned* st; };

__device__ __forceinline__ XcdBarrier xcd_barrier_post(unsigned* bar, volatile LAS unsigned* st) {
    XcdBarrier b; b.bar = bar; b.x = xb_xcc_id(); b.st = st;
    if (threadIdx.x == 0) (void)xb_add(&bar[XB_XCNT(b.x)], 1u);
    return b;
}
__device__ __forceinline__ void xcd_barrier_complete(unsigned* bar, unsigned x, unsigned& nloc, unsigned& nx) {
    const unsigned G = gridDim.x * gridDim.y * gridDim.z;
    unsigned sum, cnt, mine, sp = 0u;
    for (;;) {
        sum = 0u; cnt = 0u; mine = 0u;
#pragma unroll
        for (unsigned j = 0; j < 16; ++j) { const unsigned c = xb_ld(&bar[XB_XCNT(j)]); sum += c; cnt += (c > 0u) ? 1u : 0u; mine = (j == x) ? c : mine; }
        if (sum == G) break;
        __builtin_amdgcn_s_sleep(1);
        if ((++sp & 255u) == 0u) { if (xb_ld(&bar[XB_TMO])) break; if (sp > XB_SPIN_CAP) { atomicAdd(&bar[XB_TMO], 1u); break; } }
    }
    nloc = mine > 0u ? mine : 1u; nx = cnt > 0u ? cnt : 1u;
}
__device__ __forceinline__ void xcd_barrier(const XcdBarrier& b) {
    asm volatile("s_waitcnt vmcnt(0)" ::: "memory");
    __syncthreads();
    if (threadIdx.x == 0) {
        unsigned* bar = b.bar;
        __builtin_amdgcn_s_waitcnt(0);
        unsigned nloc = b.st[0], nx = b.st[1];
        if (nloc == 0u) { xcd_barrier_complete(bar, b.x, nloc, nx); b.st[0] = nloc; b.st[1] = nx; }
        const unsigned old = xb_add(&bar[XB_XSUB(b.x)], 1u);
        const unsigned gen = old / nloc;
        if (old + 1u == (gen + 1u) * nloc) {
            __builtin_amdgcn_fence(__ATOMIC_RELEASE, "agent");
            asm volatile("s_waitcnt vmcnt(0)" ::: "memory");
            const unsigned og = xb_add(&bar[XB_TOP], 1u);
            const unsigned tg = og / nx;
            if (og + 1u == (tg + 1u) * nx) xb_add(&bar[XB_TOPGEN], 1u);
            else XB_SPIN(xb_ld(&bar[XB_TOPGEN]) == tg, bar);
            __builtin_amdgcn_fence(__ATOMIC_ACQUIRE, "agent");
            xb_add(&bar[XB_XGEN(b.x)], 1u);
            asm volatile("s_waitcnt vmcnt(0)" ::: "memory");
        } else {
            XB_SPIN(xb_ld(&bar[XB_XGEN(b.x)]) == gen, bar);
            __builtin_amdgcn_fence(__ATOMIC_ACQUIRE, "agent");
            asm volatile("s_waitcnt vmcnt(0)" ::: "memory");
        }
    }
    __syncthreads();
}

__device__ __forceinline__ void sb_arrive(const XcdBarrier& b, unsigned* w, bool inv_early = false) {
    asm volatile("s_waitcnt vmcnt(0)" ::: "memory");
    __syncthreads();
    if (threadIdx.x == 0) {
        __builtin_amdgcn_s_waitcnt(0);
        unsigned nloc = b.st[0], nx = b.st[1];
        if (nloc == 0u) { xcd_barrier_complete(b.bar, b.x, nloc, nx); b.st[0] = nloc; b.st[1] = nx; }
        const unsigned old = xb_add(&w[64 * b.x], 1u);
        if (old + 1u == nloc) {
            __builtin_amdgcn_fence(__ATOMIC_RELEASE, "agent");
            asm volatile("s_waitcnt vmcnt(0)" ::: "memory");
            xb_add(&w[1024], 1u);
        }
        if (inv_early) asm volatile("buffer_inv sc1" ::: "memory");
    }
}
__device__ __forceinline__ void sb_wait_lane0(const XcdBarrier& b, unsigned* w) {
    const unsigned nx = b.st[1];
    XB_SPIN(xb_ld(&w[1024]) < nx, b.bar);
    __builtin_amdgcn_fence(__ATOMIC_ACQUIRE, "agent");
    asm volatile("s_waitcnt vmcnt(0)" ::: "memory");
}

__device__ __forceinline__ void sb_wait_lane0_early(const XcdBarrier& b, unsigned* w) {
    const unsigned nx = b.st[1];
    asm volatile("buffer_inv sc1" ::: "memory");
    XB_SPIN(xb_ld(&w[1024]) < nx, b.bar);
    asm volatile("s_waitcnt vmcnt(0)" ::: "memory");
}

__device__ __forceinline__ void sb_wait_lane0_noinv(const XcdBarrier& b, unsigned* w) {
    const unsigned nx = b.st[1];
    XB_SPIN(xb_ld(&w[1024]) < nx, b.bar);
    asm volatile("s_waitcnt vmcnt(0)" ::: "memory");
}

__device__ __forceinline__ float wave_sum(float v) {
#pragma unroll
    for (int o = 1; o < 64; o <<= 1) v += __shfl_xor(v, o);
    return v;
}

struct Ptrs {
    const float *x, *meta, *norm1_g, *w_in, *conv_w, *conv_b, *wq, *wk, *gate_b, *mnorm_g, *mskip, *qn_g, *kn_g, *rpb, *mbias, *w_a, *w_b, *w_out, *norm2_g, *w_ff1, *w_ff2;
    float* out; unsigned char* ws;
};
#define WSP(T, off) ((T*)(p.ws + (off)))

constexpr int SCR_STRIDE = 18368;
__device__ __forceinline__ void p0_tr64(const float* W, int ldw, int srccol0, int nvalid, bf16* WT, int pitch, int drow0, int k0, int kdst0, const float* kscale, float scale, LAS float* scr, int lane, int hi_skip = 0) {
    (void)scr;
    const int n4 = lane & 15, kq = lane >> 4; if (n4 >= 8) srccol0 += hi_skip;
    f32x4 v[2][8];
#pragma unroll
    for (int hk = 0; hk < 2; ++hk)
#pragma unroll
        for (int j = 0; j < 8; ++j) { v[hk][j] = (f32x4){0.f, 0.f, 0.f, 0.f}; if (4 * n4 < nvalid) v[hk][j] = *(const GAS f32x4*)(W + (size_t)(k0 + 32 * hk + 8 * kq + j) * ldw + srccol0 + 4 * n4); }
#pragma unroll
    for (int hk = 0; hk < 2; ++hk) { float s[8];
#pragma unroll
        for (int j = 0; j < 8; ++j) { s[j] = scale; if (kscale) s[j] *= kscale[k0 + 32 * hk + 8 * kq + j]; }
#pragma unroll
        for (int e = 0; e < 4; ++e) { v4u o; o.x = pk2(v[hk][0][e] * s[0], v[hk][1][e] * s[1]); o.y = pk2(v[hk][2][e] * s[2], v[hk][3][e] * s[3]); o.z = pk2(v[hk][4][e] * s[4], v[hk][5][e] * s[5]); o.w = pk2(v[hk][6][e] * s[6], v[hk][7][e] * s[7]);
            *(GAS v4u*)(WT + (size_t)(drow0 + 4 * n4 + e) * pitch + kdst0 + k0 + 32 * hk + 8 * kq) = o; } }
}
__device__ __forceinline__ void p0_plain(const float* W, int K, int N, bf16* WT, int pitch, int kdst0, const float* kscale, float scale, LAS float* scr, int item, int lane) {
    const int nblk = N / 64, kb = item / nblk, nb = item % nblk;
    p0_tr64(W, N, 64 * nb, 64, WT, pitch, 64 * nb, 64 * kb, kdst0, kscale, scale, scr, lane);
}
template <int PART>
__device__ __forceinline__ void p0_prologue(const Ptrs& p, LAS unsigned char* lds, int gw, int NGW, int wave, int lane) {
    LAS float* scr = (LAS float*)(lds + wave * SCR_STRIDE);
    constexpr int I_IN = 16 * (NIN / 64), I_QK = 4 * 2 * 4 * 2, I_A = 16 * 16, I_B = 8 * 16, I_O = 16 * 16;
    constexpr int NITEMS = I_IN + I_QK + I_A + I_B + I_O;
    const int gwt = wave * (NGW / NWAVES) + gw / NWAVES;
    for (int it = (PART == 0 ? gwt : I_IN + I_QK + gwt); it < (PART == 0 ? I_IN + I_QK : NITEMS); it += NGW) {
        int r = it;
        if (r < I_IN) { const int nblk = NIN / 64, kb = r / nblk, nb = r % nblk, n0 = 64 * nb;
            int src, nv;
            int hs = 0;
            if (n0 < 2048) { src = n0; nv = 64; }
            else if (n0 < 3072) { const int t = (n0 - 2048) >> 8, wcq = ((n0 - 2048) & 255) >> 6;
                src = (t < 2 ? 2064 : 2576) + (4 * (t & 1) + wcq) * 64; nv = 64; }
            else if (n0 < 3584) { src = n0 + 16; nv = 64; }
            else if (n0 < 5632) { const int k = (n0 - 3584) >> 8, wcg = ((n0 - 3584) & 255) >> 6; src = 3600 + 128 * k + 32 * wcg; nv = 64; hs = 992; }
            else if (n0 == 5632) { src = 2048; nv = 16; } else { src = 0; nv = 0; }
            p0_tr64(p.w_in, 5648, src, nv, WSP(bf16, WS_WIN), 1024, n0, 64 * kb, 0, nullptr, 1.f, scr, lane, hs); continue; } r -= I_IN;
        if (r < I_QK) { const int h = r >> 4, qk = (r >> 3) & 1, sub = r & 7, kb = sub >> 1, nb = sub & 1;
            const float* W = (qk ? p.wk : p.wq) + (size_t)h * 256 * 128;
            p0_tr64(W, 128, 64 * nb, 64, WSP(bf16, WS_WQK) + (size_t)h * 256 * 256, 256, qk * 128 + 64 * nb, 64 * kb, 0, nullptr, qk ? 0.08838834764831845f : 1.f, scr, lane); continue; } r -= I_QK;
        if (r < I_A) { p0_plain(p.w_a, 1024, 1024, WSP(bf16, WS_WA), 1536, 0, nullptr, 1.f, scr, r, lane); continue; } r -= I_A;
        if (r < I_B) { p0_plain(p.w_b, 512, 1024, WSP(bf16, WS_WA), 1536, 1024, nullptr, 1.f, scr, r, lane); continue; } r -= I_B;
        p0_plain(p.w_out, 1024, 1024, WSP(bf16, WS_WOUT), 1024, 0, nullptr, 1.f, scr, r, lane);
    }
    if constexpr (PART == 1) return;
    bf16* XN = WSP(bf16, WS_XN);
    const GAS f32x4* g1 = (const GAS f32x4*)p.norm1_g + lane;
    for (int row0 = 2 * (NGW - 1 - gwt); row0 < RP; row0 += 2 * NGW) {
        f32x4 v[2][4]; float s[2] = {0.f, 0.f};
#pragma unroll
        for (int q = 0; q < 2; ++q) { const int row = row0 + q;
            if (row < RV) { const int b = row / LSEQ, l = row - b * LSEQ;
                const float* src = (l < NMETA) ? p.meta + (size_t)l * DM : p.x + ((size_t)b * SEQ + (l - NMETA)) * DM;
                const GAS f32x4* xr = (const GAS f32x4*)src + lane;
#pragma unroll
                for (int j = 0; j < 4; ++j) v[q][j] = xr[64 * j]; }
            else {
#pragma unroll
                for (int j = 0; j < 4; ++j) v[q][j] = (f32x4){0.f, 0.f, 0.f, 0.f}; } }
#pragma unroll
        for (int q = 0; q < 2; ++q)
#pragma unroll
            for (int j = 0; j < 4; ++j) s[q] += (v[q][j].x * v[q][j].x + v[q][j].y * v[q][j].y) + (v[q][j].z * v[q][j].z + v[q][j].w * v[q][j].w);
#pragma unroll
        for (int q = 0; q < 2; ++q) { const float rs = 1.0f / sqrtf(wave_sum(s[q]) * (1.f / DM) + EPS);
            GAS unsigned long long* o8 = (GAS unsigned long long*)(XN + (size_t)(row0 + q) * DM) + lane;
#pragma unroll
            for (int j = 0; j < 4; ++j) { const f32x4 g = g1[64 * j]; o8[64 * j] = (unsigned long long)pk2(v[q][j].x * rs * g.x, v[q][j].y * rs * g.y) | ((unsigned long long)pk2(v[q][j].z * rs * g.z, v[q][j].w * rs * g.w) << 32); } }
    }
}
template <int PART>
__device__ __forceinline__ void p_ffw(const Ptrs& p, LAS unsigned char* lds, int gw, int NGW, int wave, int lane) {
    constexpr int I_1 = 16 * 64, I_2 = 64 * 16;
    for (int it = gw; it < (PART == 0 ? I_1 : I_2); it += NGW) {
        if constexpr (PART == 0) p0_plain(p.w_ff1, 1024, 4096, WSP(bf16, WS_WFF1), 1024, 0, p.norm2_g, 1.f, nullptr, it, lane);
        else p0_plain(p.w_ff2, 4096, 1024, WSP(bf16, WS_WFF2), HIDP, 0, nullptr, 1.f, nullptr, it, lane);
    }
}

struct EpiIn {
    static constexpr bool PERM = true; static constexpr int MID_T = -1; static constexpr bool WCOLS = true;
    unsigned char* ws; float* out; const float* qng; const float* kng;
    __device__ __forceinline__ void operator()(const pg8::f32x4 (&acc)[2][2][4][2], const pg8::Unit& u, int wr, int wc, int fr, int fq) const {
        using namespace pg8;
        const int row0 = u.pm * BM + wr * 64 + fr, pn = u.pn;
        const int cl = wc * 64 + 8 * fq;
        if (pn == 22) {
            if (wc == 0 && fq < 2) { float* G = (float*)(ws + WS_GATES);
#pragma unroll
                for (int ai = 0; ai < 2; ++ai)
#pragma unroll
                    for (int m = 0; m < 4; ++m) { float* rp = G + (size_t)(row0 + ai * HALF + m * 16) * 16 + 8 * fq;
                        *(f32x4*)rp = acc[ai][0][m][0]; *(f32x4*)(rp + 4) = acc[ai][0][m][1]; } }
            return; }
        if (pn >= 8 && pn < 12) {
            const bool isk = pn >= 10; const int head = 4 * (pn & 1) + wc; bf16_t* base = (bf16_t*)(ws + (isk ? WS_KN : WS_QN)) + head * 64 + 8 * fq;
            const float* gp = (isk ? kng : qng) + 8 * fq; float gn[2][8];
#pragma unroll
            for (int bj = 0; bj < 2; ++bj)
#pragma unroll
                for (int e = 0; e < 8; ++e) gn[bj][e] = gp[32 * bj + e] * (isk ? 1.0f : 0.125f * 1.4426950408889634f);
#pragma unroll
            for (int ai = 0; ai < 2; ++ai)
#pragma unroll
                for (int m = 0; m < 4; ++m) { const int row = row0 + ai * HALF + m * 16; float ss = 0.f;
#pragma unroll
                    for (int bj = 0; bj < 2; ++bj)
#pragma unroll
                        for (int n = 0; n < 2; ++n) { const f32x4 v = acc[ai][bj][m][n]; ss += (v[0] * v[0] + v[1] * v[1]) + (v[2] * v[2] + v[3] * v[3]); }
                    ss += __shfl_xor(ss, 16); ss += __shfl_xor(ss, 32);
                    const float rs = 1.0f / sqrtf(ss * (1.f / 64.f) + EPS);
#pragma unroll
                    for (int bj = 0; bj < 2; ++bj) { const f32x4 v0 = acc[ai][bj][m][0] * rs, v1 = acc[ai][bj][m][1] * rs;
                        u32x4 w; w.x = cvt_pk_bf16(v0[0] * gn[bj][0], v0[1] * gn[bj][1]); w.y = cvt_pk_bf16(v0[2] * gn[bj][2], v0[3] * gn[bj][3]); w.z = cvt_pk_bf16(v1[0] * gn[bj][4], v1[1] * gn[bj][5]); w.w = cvt_pk_bf16(v1[2] * gn[bj][6], v1[3] * gn[bj][7]);
                        *(u32x4*)(base + (size_t)row * 512 + 32 * bj) = w; } }
            return; }
        bf16_t* base; int ldc, col; bool sig = false, tok = false;
        if (pn < 4) { base = (bf16_t*)(ws + WS_XM); ldc = 1024; col = pn * 256; }
        else if (pn < 8) { base = (bf16_t*)(ws + WS_SO); ldc = 1024; col = (pn - 4) * 256; sig = true; }
        else if (pn < 14) { base = (bf16_t*)(ws + WS_VR); ldc = 512; col = (pn - 12) * 256; }
        else {
            bf16_t* GR = (bf16_t*)out; bf16_t* GB = (bf16_t*)out + (size_t)MTOK * 1024; const int gcol = (pn - 14) * 128 + wc * 32 + 8 * fq;
#pragma unroll
            for (int ai = 0; ai < 2; ++ai)
#pragma unroll
                for (int m = 0; m < 4; ++m) {
                    int row = row0 + ai * HALF + m * 16; const int b = row / LSEQ, l = row - b * LSEQ; if (row >= RV || l < NMETA) continue; row = b * SEQ + l - NMETA;
                    float gr[8], gb[8];
#pragma unroll
                    for (int n = 0; n < 2; ++n)
#pragma unroll
                        for (int e = 0; e < 4; ++e) { const float ea = __expf(-acc[ai][0][m][n][e]), eb2 = __expf(-acc[ai][1][m][n][e]); const float sb = __builtin_amdgcn_rcpf(1.0f + eb2);
                            gb[4 * n + e] = sb; gr[4 * n + e] = (1.0f + eb2) * __builtin_amdgcn_rcpf(1.0f + ea); }
                    u32x4 w; w.x = cvt_pk_bf16(gr[0], gr[1]); w.y = cvt_pk_bf16(gr[2], gr[3]); w.z = cvt_pk_bf16(gr[4], gr[5]); w.w = cvt_pk_bf16(gr[6], gr[7]);
                    *(u32x4*)(GR + (size_t)row * 1024 + gcol) = w;
                    w.x = cvt_pk_bf16(gb[0], gb[1]); w.y = cvt_pk_bf16(gb[2], gb[3]); w.z = cvt_pk_bf16(gb[4], gb[5]); w.w = cvt_pk_bf16(gb[6], gb[7]);
                    *(u32x4*)(GB + (size_t)row * 1024 + gcol) = w; }
            return; }
#pragma unroll
        for (int ai = 0; ai < 2; ++ai)
#pragma unroll
            for (int m = 0; m < 4; ++m) {
                int row = row0 + ai * HALF + m * 16; bool ok = true;
                if (tok) { const int b = row / LSEQ, l = row - b * LSEQ; ok = (row < RV) && (l >= NMETA); row = b * SEQ + l - NMETA; }
                if (!ok) continue;
                bf16_t* rowp = base + (size_t)row * ldc + col + cl;
#pragma unroll
                for (int bj = 0; bj < 2; ++bj) { f32x4 v0 = acc[ai][bj][m][0], v1 = acc[ai][bj][m][1];
                    if (sig) {
#pragma unroll
                        for (int e = 0; e < 4; ++e) { v0[e] = sigmoidf_(v0[e]); v1[e] = sigmoidf_(v1[e]); } }
                    u32x4 w; w.x = cvt_pk_bf16(v0[0], v0[1]); w.y = cvt_pk_bf16(v0[2], v0[3]); w.z = cvt_pk_bf16(v1[0], v1[1]); w.w = cvt_pk_bf16(v1[2], v1[3]);
                    *(u32x4*)(rowp + bj * 32) = w; } }
    }
};

__device__ __forceinline__ void conv_silu16(const bf16* XM, int b, int l, int lane, const float (&cw)[3][16], const float (&cb)[16], float (&o)[16]) {
    const bf16* r1 = XM + ((size_t)b * LSEQ + l) * DM + 16 * lane;
    v4u a0[2] = {{0, 0, 0, 0}, {0, 0, 0, 0}}, a1[2], a2[2] = {{0, 0, 0, 0}, {0, 0, 0, 0}};
    a1[0] = *(const GAS v4u*)r1; a1[1] = *(const GAS v4u*)(r1 + 8);
    if (l > 0) { a0[0] = *(const GAS v4u*)(r1 - DM); a0[1] = *(const GAS v4u*)(r1 - DM + 8); }
    if (l < LSEQ - 1) { a2[0] = *(const GAS v4u*)(r1 + DM); a2[1] = *(const GAS v4u*)(r1 + DM + 8); }
#pragma unroll
    for (int q = 0; q < 2; ++q)
#pragma unroll
        for (int e = 0; e < 4; ++e) {
            const int c = q * 8 + e * 2;
            const float y0 = cb[c] + cw[0][c] * bflo(a0[q][e]) + cw[1][c] * bflo(a1[q][e]) + cw[2][c] * bflo(a2[q][e]);
            const float y1 = cb[c + 1] + cw[0][c + 1] * bfhi(a0[q][e]) + cw[1][c + 1] * bfhi(a1[q][e]) + cw[2][c + 1] * bfhi(a2[q][e]);
            o[c] = y0 * sigmoidf_(y0); o[c + 1] = y1 * sigmoidf_(y1); }
}
__device__ __forceinline__ void load_conv_w(const Ptrs& p, int lane, float (&cw)[3][16], float (&cb)[16]) {
#pragma unroll
    for (int j = 0; j < 3; ++j)
#pragma unroll
        for (int q = 0; q < 4; ++q) { const f32x4 v = *(const GAS f32x4*)(p.conv_w + (size_t)j * DM + 16 * lane + 4 * q); cw[j][4 * q] = v.x; cw[j][4 * q + 1] = v.y; cw[j][4 * q + 2] = v.z; cw[j][4 * q + 3] = v.w; }
#pragma unroll
    for (int q = 0; q < 4; ++q) { const f32x4 v = *(const GAS f32x4*)(p.conv_b + 16 * lane + 4 * q); cb[4 * q] = v.x; cb[4 * q + 1] = v.y; cb[4 * q + 2] = v.z; cb[4 * q + 3] = v.w; }
}
__device__ __forceinline__ v4u conv_silu8_raw(const v4u a0, const v4u a1, const v4u a2, const float (&cw)[3][8], const float (&cb)[8]) {
    v4u o;
#pragma unroll
    for (int e = 0; e < 4; ++e) { const int c = 2 * e;
        const float y0 = cb[c] + cw[0][c] * bflo(a0[e]) + cw[1][c] * bflo(a1[e]) + cw[2][c] * bflo(a2[e]);
        const float y1 = cb[c + 1] + cw[0][c + 1] * bfhi(a0[e]) + cw[1][c + 1] * bfhi(a1[e]) + cw[2][c + 1] * bfhi(a2[e]);
        o[e] = pk2(y0 * sigmoidf_(y0), y1 * sigmoidf_(y1)); }
    return o;
}
__device__ __forceinline__ v4u conv_silu8(const bf16* XM, int b, int l, int col0, const float (&cw)[3][8], const float (&cb)[8]) {
    const bf16* r1 = XM + ((size_t)b * LSEQ + l) * DM + col0;
    v4u a0 = {0, 0, 0, 0}, a2 = {0, 0, 0, 0}; const v4u a1 = *(const GAS v4u*)r1;
    if (l > 0) a0 = *(const GAS v4u*)(r1 - DM);
    if (l < LSEQ - 1) a2 = *(const GAS v4u*)(r1 + DM);
    return conv_silu8_raw(a0, a1, a2, cw, cb);
}
__device__ __forceinline__ void load_conv_w8(const Ptrs& p, int col0, float (&cw)[3][8], float (&cb)[8]) {
#pragma unroll
    for (int j = 0; j < 3; ++j)
#pragma unroll
        for (int q = 0; q < 2; ++q) { const f32x4 v = *(const GAS f32x4*)(p.conv_w + (size_t)j * DM + col0 + 4 * q); cw[j][4 * q] = v.x; cw[j][4 * q + 1] = v.y; cw[j][4 * q + 2] = v.z; cw[j][4 * q + 3] = v.w; }
#pragma unroll
    for (int q = 0; q < 2; ++q) { const f32x4 v = *(const GAS f32x4*)(p.conv_b + col0 + 4 * q); cb[4 * q] = v.x; cb[4 * q + 1] = v.y; cb[4 * q + 2] = v.z; cb[4 * q + 3] = v.w; }
}
__device__ __forceinline__ void gate_scalars(const Ptrs& p, int gw, int NGW, int lane) {
    const float* GT = WSP(float, WS_GATES); float* SB = WSP(float, WS_SCAL); float* SG = SB + SCAL_ARR; float* SPM = SG + SCAL_ARR;
    for (int it = NGW - 1 - gw; it < 32 * NCHUNK; it += NGW) {
        const int seq = it / NCHUNK, c = it - seq * NCHUNK, dir = seq & 1, h = (seq >> 1) & 3, b = seq >> 3;
        const int l = dir ? (LSEQ - 1 - 64 * c - lane) : (64 * c + lane - 48);
        float li = -1e9f, lf = 0.f;
        if (l >= 0) { const float* gr = GT + ((size_t)b * LSEQ + l) * 16 + dir * 8 + h;
            li = gr[0] + p.gate_b[(dir * 2) * 4 + h];
            const float f = gr[4] + p.gate_b[(dir * 2 + 1) * 4 + h];
            lf = -(fmaxf(-f, 0.f) + __logf(1.0f + __expf(-fabsf(f)))); }
        float bs = lf;
#pragma unroll
        for (int o = 1; o < 64; o <<= 1) { const float t = __shfl_up(bs, o); if (lane >= o) bs += t; }
        const float gg = li - bs; float pm = gg;
#pragma unroll
        for (int o = 1; o < 64; o <<= 1) { const float t = __shfl_up(pm, o); if (lane >= o) pm = fmaxf(pm, t); }
        const size_t idx = (size_t)it * 64 + lane; SB[idx] = bs; SG[idx] = gg; SPM[idx] = pm;
    }
}
__device__ __forceinline__ void p3_head(const Ptrs& p, LAS unsigned char* lds, int pm, int h, int vcu, int gw, int NGW, int wave, int lane) {
    const bf16* XM = WSP(bf16, WS_XM); bf16* XC = WSP(bf16, WS_XC);
    const int col0 = h * 256 + 8 * (lane & 31);
    const bool extra = vcu < 16;
    const int rt = vcu & 3, hh = (vcu >> 2) & 3, c16 = lane & 15, g = lane >> 4;
    bf16x8 bfr[2][8];
    { float cw[3][8], cb[8]; load_conv_w8(p, col0, cw, cb);
      const int rbase = 256 * pm + 32 * wave + 16 * (lane >> 5);
      v4u rw[18];
#pragma unroll
      for (int i = 0; i < 18; ++i) { const int row = rbase + i - 1, b = (row < 0 ? 0 : row) / LSEQ, l = row - b * LSEQ; rw[i] = (v4u){0, 0, 0, 0};
          if (row >= 0 && row < RV) rw[i] = *(const GAS v4u*)(XM + (size_t)row * DM + col0); (void)l; }
      v4u xa0 = {0, 0, 0, 0}, xa1 = {0, 0, 0, 0}, xa2 = {0, 0, 0, 0};
      const int xrow = MTOK + 16 * rt + 2 * wave + (lane >> 5), xb = xrow / LSEQ, xl = xrow - xb * LSEQ, colx = hh * 256 + 8 * (lane & 31);
      if (extra) { const bf16* r1 = XM + (size_t)xrow * DM + colx; xa1 = *(const GAS v4u*)r1; if (xl > 0) xa0 = *(const GAS v4u*)(r1 - DM); if (xl < LSEQ - 1) xa2 = *(const GAS v4u*)(r1 + DM);
#pragma unroll
          for (int t2 = 0; t2 < 2; ++t2) { const bf16* bp = WSP(bf16, WS_WQK) + (size_t)(hh * 256 + 16 * (2 * wave + t2) + c16) * 256 + 8 * g;
#pragma unroll
              for (int ks = 0; ks < 8; ++ks) bfr[t2][ks] = *(const GAS bf16x8*)(bp + 32 * ks); } }
#pragma unroll
      for (int i = 0; i < 16; ++i) { const int row = rbase + i, b = row / LSEQ, l = row - b * LSEQ;
          const v4u a0 = (l > 0) ? rw[i] : (v4u){0, 0, 0, 0}, a1 = rw[i + 1], a2 = (l < LSEQ - 1) ? rw[i + 2] : (v4u){0, 0, 0, 0};
          v4u o;
#pragma unroll
          for (int e = 0; e < 4; ++e) { const int cc = 2 * e;
              const float y0 = cb[cc] + cw[0][cc] * bflo(a0[e]) + cw[1][cc] * bflo(a1[e]) + cw[2][cc] * bflo(a2[e]);
              const float y1 = cb[cc + 1] + cw[0][cc + 1] * bfhi(a0[e]) + cw[1][cc + 1] * bfhi(a1[e]) + cw[2][cc + 1] * bfhi(a2[e]);
              o[e] = pk2(y0 * sigmoidf_(y0), y1 * sigmoidf_(y1)); }
          *(GAS v4u*)(XC + (size_t)row * DM + col0) = o; }
      if (extra) { float cwx[3][8], cbx[8]; load_conv_w8(p, colx, cwx, cbx);
          *(LAS v4u*)(lds + (2 * wave + (lane >> 5)) * 528 + 16 * (lane & 31)) = conv_silu8_raw(xa0, xa1, xa2, cwx, cbx); } }
    gate_scalars(p, gw, NGW, lane);
    if (extra) {
        __syncthreads();
        bf16x8 af[8];
#pragma unroll
        for (int ks = 0; ks < 8; ++ks) af[ks] = *(const LAS bf16x8*)(lds + c16 * 528 + (32 * ks + 8 * g) * 2);
#pragma unroll
        for (int t2 = 0; t2 < 2; ++t2) { const int nt = 2 * wave + t2;
            f32x4 acc = (f32x4){0.f, 0.f, 0.f, 0.f};
#pragma unroll
            for (int ks = 0; ks < 8; ++ks) acc = __builtin_amdgcn_mfma_f32_16x16x32_bf16(bfr[t2][ks], af[ks], acc, 0, 0, 0);
            v2u o; o.x = pg8::cvt_pk_safe(acc[0], acc[1]); o.y = pg8::cvt_pk_safe(acc[2], acc[3]);
            *(GAS v2u*)(WSP(bf16, WS_QKM) + (size_t)(MTOK + 16 * rt + c16) * 1024 + hh * 256 + 16 * nt + 4 * g) = o; }
    }
    asm volatile("s_waitcnt vmcnt(0)" ::: "memory"); __syncthreads();
}
__device__ __forceinline__ void p3_pre(const Ptrs& p, LAS unsigned char* lds, int vcu, int gw, int NGW, int wave, int lane) {
    const bf16* XM = WSP(bf16, WS_XM);
    const bool extra = vcu < 16;
    const int rt = vcu & 3, hh = (vcu >> 2) & 3, c16 = lane & 15, g = lane >> 4;
    bf16x8 bfr[2][8];
    if (extra) {
        v4u xa0 = {0, 0, 0, 0}, xa1, xa2 = {0, 0, 0, 0};
        const int xrow = MTOK + 16 * rt + 2 * wave + (lane >> 5), xb = xrow / LSEQ, xl = xrow - xb * LSEQ, colx = hh * 256 + 8 * (lane & 31);
        const bf16* r1 = XM + (size_t)xrow * DM + colx; xa1 = *(const GAS v4u*)r1; if (xl > 0) xa0 = *(const GAS v4u*)(r1 - DM); if (xl < LSEQ - 1) xa2 = *(const GAS v4u*)(r1 + DM);
#pragma unroll
        for (int t2 = 0; t2 < 2; ++t2) { const bf16* bp = WSP(bf16, WS_WQK) + (size_t)(hh * 256 + 16 * (2 * wave + t2) + c16) * 256 + 8 * g;
#pragma unroll
            for (int ks = 0; ks < 8; ++ks) bfr[t2][ks] = *(const GAS bf16x8*)(bp + 32 * ks); }
        float cwx[3][8], cbx[8]; load_conv_w8(p, colx, cwx, cbx);
        *(LAS v4u*)(lds + (2 * wave + (lane >> 5)) * 528 + 16 * (lane & 31)) = conv_silu8_raw(xa0, xa1, xa2, cwx, cbx);
    }
    gate_scalars(p, gw, NGW, lane);
    if (extra) {
        __syncthreads();
        bf16x8 af[8];
#pragma unroll
        for (int ks = 0; ks < 8; ++ks) af[ks] = *(const LAS bf16x8*)(lds + c16 * 528 + (32 * ks + 8 * g) * 2);
#pragma unroll
        for (int t2 = 0; t2 < 2; ++t2) { const int nt = 2 * wave + t2;
            f32x4 acc = (f32x4){0.f, 0.f, 0.f, 0.f};
#pragma unroll
            for (int ks = 0; ks < 8; ++ks) acc = __builtin_amdgcn_mfma_f32_16x16x32_bf16(bfr[t2][ks], af[ks], acc, 0, 0, 0);
            v2u o; o.x = pg8::cvt_pk_safe(acc[0], acc[1]); o.y = pg8::cvt_pk_safe(acc[2], acc[3]);
            *(GAS v2u*)(WSP(bf16, WS_QKM) + (size_t)(MTOK + 16 * rt + c16) * 1024 + hh * 256 + 16 * nt + 4 * g) = o; }
    }
    __syncthreads();
}

struct EpiStoreBf16 {
    static constexpr bool PERM = true; static constexpr int MID_T = -1; static constexpr bool WCOLS = false;
    bf16* O; int ldc;
    __device__ __forceinline__ void operator()(const pg8::f32x4 (&acc)[2][2][4][2], const pg8::Unit& u, int wr, int wc, int fr, int fq) const {
        using namespace pg8;
        const int row0 = u.pm * BM + wr * 64 + fr, col0 = u.pn * BM + wc * 32 + 8 * fq;
#pragma unroll
        for (int ai = 0; ai < 2; ++ai)
#pragma unroll
            for (int m = 0; m < 4; ++m) { bf16* rowp = O + (size_t)(row0 + ai * HALF + m * 16) * ldc + col0;
#pragma unroll
                for (int bj = 0; bj < 2; ++bj) { const f32x4 v0 = acc[ai][bj][m][0], v1 = acc[ai][bj][m][1];
                    u32x4 w; w.x = cvt_pk_bf16(v0[0], v0[1]); w.y = cvt_pk_bf16(v0[2], v0[3]); w.z = cvt_pk_bf16(v1[0], v1[1]); w.w = cvt_pk_bf16(v1[2], v1[3]);
                    *(u32x4*)(rowp + bj * HALF) = w; } }
    }
};
struct EpiMix {
    static constexpr bool PERM = true; static constexpr int MID_T = 16; static constexpr bool WCOLS = true;
    bf16* MIX; const bf16* GA; const bf16* GB;
    __device__ __forceinline__ void mid(pg8::f32x4 (&acc)[2][2][4][2], const pg8::Unit& u, int wr, int wc, int fr, int fq) const {
        using namespace pg8;
        int row0 = u.pm * BM + wr * 64 + fr; const int col0 = u.pn * BM + wc * 64 + 8 * fq;
        asm volatile("" : "+v"(row0));
#pragma unroll
        for (int ai = 0; ai < 2; ++ai)
#pragma unroll
            for (int m2 = 0; m2 < 2; ++m2) { u32x4 a[2][2];
#pragma unroll
                for (int mm = 0; mm < 2; ++mm)
#pragma unroll
                    for (int bj = 0; bj < 2; ++bj) a[mm][bj] = *(const u32x4*)(GA + (size_t)(row0 + ai * HALF + (2 * m2 + mm) * 16) * 1024 + col0 + bj * 32);
#pragma unroll
                for (int mm = 0; mm < 2; ++mm)
#pragma unroll
                    for (int bj = 0; bj < 2; ++bj) { const u32x4 g4 = a[mm][bj]; f32x4& v0 = acc[ai][bj][2 * m2 + mm][0]; f32x4& v1 = acc[ai][bj][2 * m2 + mm][1];
                        v0[0] *= bflo(g4.x); v0[1] *= bfhi(g4.x); v0[2] *= bflo(g4.y); v0[3] *= bfhi(g4.y); v1[0] *= bflo(g4.z); v1[1] *= bfhi(g4.z); v1[2] *= bflo(g4.w); v1[3] *= bfhi(g4.w); }
                asm volatile("" ::: "memory"); }
    }
    __device__ __forceinline__ void operator()(const pg8::f32x4 (&acc)[2][2][4][2], const pg8::Unit& u, int wr, int wc, int fr, int fq) const {
        using namespace pg8;
        const int row0 = u.pm * BM + wr * 64 + fr, col0 = u.pn * BM + wc * 64 + 8 * fq;
#pragma unroll
        for (int ai = 0; ai < 2; ++ai)
#pragma unroll
            for (int m = 0; m < 4; ++m) { const size_t off = (size_t)(row0 + ai * HALF + m * 16) * 1024 + col0;
#pragma unroll
                for (int bj = 0; bj < 2; ++bj) { const f32x4 v0 = acc[ai][bj][m][0], v1 = acc[ai][bj][m][1];
                    const u32x4 gv = *(const u32x4*)(GB + off + bj * 32);
                    u32x4 w; w.x = cvt_pk_bf16(v0[0] * bflo(gv.x), v0[1] * bfhi(gv.x)); w.y = cvt_pk_bf16(v0[2] * bflo(gv.y), v0[3] * bfhi(gv.y)); w.z = cvt_pk_bf16(v1[0] * bflo(gv.z), v1[1] * bfhi(gv.z)); w.w = cvt_pk_bf16(v1[2] * bflo(gv.w), v1[3] * bfhi(gv.w));
                    *(u32x4*)(MIX + off + bj * 32) = w; } }
    }
};
struct EpiOut {
    static constexpr bool PERM = true; static constexpr int MID_T = -1; static constexpr bool WCOLS = true;
    const float* X; float* OUT; bf16* H2B; float* ROWSS;
    __device__ __forceinline__ void operator()(const pg8::f32x4 (&acc)[2][2][4][2], const pg8::Unit& u, int wr, int wc, int fr, int fq) const {
        using namespace pg8;
        const int row0 = u.pm * BM + wr * 64 + fr, col0 = u.pn * BM + wc * 64 + 8 * fq;
#pragma unroll
        for (int ai = 0; ai < 2; ++ai)
#pragma unroll
            for (int m = 0; m < 4; ++m) { const int row = row0 + ai * HALF + m * 16; const size_t off = (size_t)row * 1024 + col0; float ss = 0.f;
#pragma unroll
                for (int bj = 0; bj < 2; ++bj) { const size_t o2 = off + bj * 32;
                    const f32x4 h0 = *(const f32x4*)(X + o2) + acc[ai][bj][m][0], h1 = *(const f32x4*)(X + o2 + 4) + acc[ai][bj][m][1];
                    ss += ((h0[0] * h0[0] + h0[1] * h0[1]) + (h0[2] * h0[2] + h0[3] * h0[3])) + ((h1[0] * h1[0] + h1[1] * h1[1]) + (h1[2] * h1[2] + h1[3] * h1[3]));
                    u32x4 w; w.x = cvt_pk_bf16(h0[0], h0[1]); w.y = cvt_pk_bf16(h0[2], h0[3]); w.z = cvt_pk_bf16(h1[0], h1[1]); w.w = cvt_pk_bf16(h1[2], h1[3]); *(u32x4*)(H2B + o2) = w; }
                ss += __shfl_xor(ss, 16); ss += __shfl_xor(ss, 32);
                if (fq == 0) ROWSS[(size_t)row * 16 + u.pn * 4 + wc] = ss; }
    }
};
struct EpiFF1 {
    static constexpr bool PERM = true; static constexpr int MID_T = -1; static constexpr bool WCOLS = true;
    bf16* HID; const pg8::PG8_LAS_F* RS;
    __device__ __forceinline__ void operator()(const pg8::f32x4 (&acc)[2][2][4][2], const pg8::Unit& u, int wr, int wc, int fr, int fq) const {
        using namespace pg8;
        const int row0 = u.pm * BM + wr * 64 + fr, col0 = u.pn * BM + wc * 64 + 8 * fq;
        const PG8_LAS_F* rsu = RS + (u.idx & 3) * 256 + wr * 64 + fr;
#pragma unroll
        for (int ai = 0; ai < 2; ++ai)
#pragma unroll
            for (int m = 0; m < 4; ++m) { const int row = row0 + ai * HALF + m * 16;
                const float rs = rsu[ai * HALF + m * 16];
                bf16* rowp = HID + (size_t)row * HIDP + col0;
#pragma unroll
                for (int bj = 0; bj < 2; ++bj) { f32x4 v0 = acc[ai][bj][m][0] * rs, v1 = acc[ai][bj][m][1] * rs;
#pragma unroll
                    for (int e = 0; e < 4; ++e) { const float z0 = fmaxf(v0[e], 0.f), z1 = fmaxf(v1[e], 0.f); v0[e] = z0 * z0; v1[e] = z1 * z1; }
                    u32x4 w; w.x = cvt_pk_bf16(v0[0], v0[1]); w.y = cvt_pk_bf16(v0[2], v0[3]); w.z = cvt_pk_bf16(v1[0], v1[1]); w.w = cvt_pk_bf16(v1[2], v1[3]);
                    *(u32x4*)(rowp + bj * 32) = w; } }
    }
};
template <class Sched>
__device__ __forceinline__ void ff1_row_scales(const float* ROWSS, const Sched& S, PG8_LAS unsigned char* lds, int tid) {
    PG8_LAS float* T = (PG8_LAS float*)(lds + RING_BYTES);
#pragma unroll
    for (int j = 0; j < 2; ++j) { const int e = tid + j * NTHR, ui = e >> 8, r = e & 255; pg8::Unit u;
        float rs = 0.f;
        if (S.next(ui, u)) { const f32x4* rp = (const f32x4*)(ROWSS + (size_t)(u.pm * 256 + r) * 16); const f32x4 a = rp[0], b = rp[1], c = rp[2], d = rp[3];
            const float tot = ((a[0] + a[1]) + (a[2] + a[3])) + ((b[0] + b[1]) + (b[2] + b[3])) + ((c[0] + c[1]) + (c[2] + c[3])) + ((d[0] + d[1]) + (d[2] + d[3]));
            rs = 1.0f / sqrtf(tot * (1.f / 1024.f) + EPS); }
        T[e] = rs; }
}
struct EpiFF2 {
    static constexpr bool PERM = false; static constexpr int MID_T = -1; static constexpr bool WCOLS = false;
    float* OUT; const bf16* H2B;
    __device__ __forceinline__ void operator()(const pg8::f32x4 (&acc)[2][2][4][2], const pg8::Unit& u, int wr, int wc, int fr, int fq) const {
        using namespace pg8;
        const int row0 = u.pm * BM + wr * 64 + fr, col0 = u.pn * BM + wc * 32 + 4 * fq;
#pragma unroll
        for (int ai = 0; ai < 2; ++ai)
#pragma unroll
            for (int m = 0; m < 4; ++m) { const size_t off = (size_t)(row0 + ai * HALF + m * 16) * 1024 + col0;
#pragma unroll
                for (int bj = 0; bj < 2; ++bj)
#pragma unroll
                    for (int n = 0; n < 2; ++n) { const size_t o2 = off + bj * HALF + n * 16; const u32x2 hb = *(const u32x2*)(H2B + o2);
                        *(f32x4*)(OUT + o2) = (f32x4){bflo(hb.x), bfhi(hb.x), bflo(hb.y), bfhi(hb.y)} + acc[ai][bj][m][n]; } }
    }
};

template <class Pre>
__device__ __forceinline__ void p3_fused(const Ptrs& p, PG8_LAS unsigned char* lds, int pm, int h, const Pre& pre) {
    using namespace pg8;
    const int tid = threadIdx.x, wid = __builtin_amdgcn_readfirstlane(tid >> 6), lane = tid & 63, wr = wid >> 2, wc = wid & 3, fr = lane & 15, fq = lane >> 4;
    const bf16* XM = WSP(bf16, WS_XM);
    PG8_LAS float* cwl = (PG8_LAS float*)(lds + RING_BYTES);
    for (int i = tid; i < 1024; i += NTHR) { const int j = i >> 8, c = i & 255; cwl[i] = (j < 3) ? p.conv_w[(size_t)j * DM + h * 256 + c] : p.conv_b[h * 256 + c]; }
    unsigned voffB[2];
#pragma unroll
    for (int i = 0; i < 2; ++i) { int R, C; stage_rc(tid * 16 + i * 8192, R, C); const int Rb = (R & ~31) + perm32(R & 31); voffB[i] = (unsigned)(Rb * 256 + C) * 2u; }
    const char* cB = (const char*)(WSP(bf16, WS_WQK) + (size_t)h * 256 * 256);
    const size_t hstepB = (size_t)HALF * 256 * 2, kstep = (size_t)BK * 2;
    const unsigned ldsw = (unsigned)wid * 1024u;
    const int aoff = lds_byte(wr * 64 + fr, fq * 8), boff = lds_byte(wc * 32 + fr, fq * 8);
#define P3_SA(b, hh) (((b) * 2 + (hh)) * HTB)
#define P3_SB(b, hh) ((4 + (b) * 2 + (hh)) * HTB)
#define P3_STAGE(bufoff, gbase) do { _Pragma("unroll") for (int _i = 0; _i < 2; ++_i) \
        __builtin_amdgcn_global_load_lds((const unsigned*)((const char*)(gbase) + voffB[_i]), (PG8_LAS unsigned*)(lds + (bufoff) + ldsw + _i * 8192), 16, 0, 0); } while (0)
    const int pc = tid & 7, rg = tid >> 3;
    const int rowb = 256 * pm + 4 * rg;
    unsigned zmask = 0u;
#pragma unroll
    for (int j = 0; j < 4; ++j) { const int row = rowb + j, b = row / LSEQ, l = row - b * LSEQ; zmask |= (l == 0 ? 1u : 0u) << j; zmask |= (l == LSEQ - 1 ? 1u : 0u) << (4 + j); }
    int wdst[4];
#pragma unroll
    for (int j = 0; j < 4; ++j) { const int r = 4 * rg + j; wdst[j] = (r >> 7) * HTB + lds_byte(r & 127, 8 * pc); }
    const bf16* xsrc = XM + (size_t)(rowb - 1) * DM + h * 256 + 8 * pc;
    v4u rw[6];
    auto ldraw = [&](int t) {
#pragma unroll
        for (int i = 0; i < 6; ++i) { rw[i] = (v4u){0, 0, 0, 0}; if (rowb - 1 + i >= 0) rw[i] = *(const GAS v4u*)(xsrc + (size_t)i * DM + 64 * t); }
    };
    auto convw = [&](int t, int s) {
        float cw[3][8], cb[8];
#pragma unroll
        for (int j = 0; j < 3; ++j) { const f32x4 a = *(const PG8_LAS f32x4*)(cwl + j * 256 + 64 * t + 8 * pc), b4 = *(const PG8_LAS f32x4*)(cwl + j * 256 + 64 * t + 8 * pc + 4);
            cw[j][0] = a.x; cw[j][1] = a.y; cw[j][2] = a.z; cw[j][3] = a.w; cw[j][4] = b4.x; cw[j][5] = b4.y; cw[j][6] = b4.z; cw[j][7] = b4.w; }
        { const f32x4 a = *(const PG8_LAS f32x4*)(cwl + 768 + 64 * t + 8 * pc), b4 = *(const PG8_LAS f32x4*)(cwl + 768 + 64 * t + 8 * pc + 4);
          cb[0] = a.x; cb[1] = a.y; cb[2] = a.z; cb[3] = a.w; cb[4] = b4.x; cb[5] = b4.y; cb[6] = b4.z; cb[7] = b4.w; }
#pragma unroll
        for (int j = 0; j < 4; ++j) { const v4u z = {0, 0, 0, 0};
            const v4u o = conv_silu8_raw(((zmask >> j) & 1u) ? z : rw[j], rw[j + 1], ((zmask >> (4 + j)) & 1u) ? z : rw[j + 2], cw, cb);
            *(PG8_LAS v4u*)(lds + P3_SA(s, 0) + wdst[j]) = o; }
    };
    f32x4 acc[2][2][4][2];
#pragma unroll
    for (int a = 0; a < 2; ++a)
#pragma unroll
        for (int b = 0; b < 2; ++b)
#pragma unroll
            for (int m = 0; m < 4; ++m)
#pragma unroll
                for (int n = 0; n < 2; ++n) acc[a][b][m][n] = (f32x4){0.f, 0.f, 0.f, 0.f};
    ldraw(0);
    P3_STAGE(P3_SB(0, 0), cB); P3_STAGE(P3_SB(0, 1), cB + hstepB);
    pre();
    __syncthreads();
    convw(0, 0);
    asm volatile("s_waitcnt vmcnt(0) lgkmcnt(0)" ::: "memory"); __syncthreads();
#pragma unroll 1
    for (int t = 0; t < 4; ++t) {
        const int s = t & 1;
        if (t + 1 < 4) { ldraw(t + 1); P3_STAGE(P3_SB(s ^ 1, 0), cB + (size_t)(t + 1) * kstep); P3_STAGE(P3_SB(s ^ 1, 1), cB + hstepB + (size_t)(t + 1) * kstep); }
        __builtin_amdgcn_sched_barrier(0);
        { bf16x8 B0[2][2], B1[2][2], At[4][2];
#pragma unroll
          for (int n = 0; n < 2; ++n)
#pragma unroll
              for (int k = 0; k < 2; ++k) { B0[n][k] = *(const PG8_LAS bf16x8*)(lds + P3_SB(s, 0) + boff + n * 2048 + k * 1024); B1[n][k] = *(const PG8_LAS bf16x8*)(lds + P3_SB(s, 1) + boff + n * 2048 + k * 1024); }
#pragma unroll
          for (int ai = 0; ai < 2; ++ai) {
#pragma unroll
              for (int m = 0; m < 4; ++m)
#pragma unroll
                  for (int k = 0; k < 2; ++k) At[m][k] = *(const PG8_LAS bf16x8*)(lds + P3_SA(s, ai) + aoff + m * 2048 + k * 1024);
#pragma unroll
              for (int m = 0; m < 4; ++m)
#pragma unroll
                  for (int n = 0; n < 2; ++n)
#pragma unroll
                      for (int k = 0; k < 2; ++k) { acc[ai][0][m][n] = __builtin_amdgcn_mfma_f32_16x16x32_bf16(B0[n][k], At[m][k], acc[ai][0][m][n], 0, 0, 0);
                          acc[ai][1][m][n] = __builtin_amdgcn_mfma_f32_16x16x32_bf16(B1[n][k], At[m][k], acc[ai][1][m][n], 0, 0, 0); } } }
        __builtin_amdgcn_sched_barrier(0);
        if (t + 1 < 4) convw(t + 1, s ^ 1);
        asm volatile("s_waitcnt vmcnt(0) lgkmcnt(0)" ::: "memory"); __syncthreads();
    }
#undef P3_SA
#undef P3_SB
#undef P3_STAGE
    { EpiStoreBf16 E{WSP(bf16, WS_QKM), 1024}; Unit u; u.pm = pm; u.pn = h; E(acc, u, wr, wc, fr, fq); }
    asm volatile("s_waitcnt vmcnt(0)" ::: "memory"); __syncthreads();
}

__device__ __forceinline__ s16x4 ds_tr16(const LAS unsigned char* a) { return __builtin_bit_cast(s16x4, __builtin_amdgcn_ds_read_tr16_b64_v4i16((LAS s16x4*)a)); }
__device__ __forceinline__ bf16x8 cat8(s16x4 lo, s16x4 hi) { return (bf16x8){lo[0], lo[1], lo[2], lo[3], hi[0], hi[1], hi[2], hi[3]}; }
__device__ __forceinline__ bf16x8 pack8(const float* f) { v4u w; w.x = pg8::cvt_pk_safe(f[0], f[1]); w.y = pg8::cvt_pk_safe(f[2], f[3]); w.z = pg8::cvt_pk_safe(f[4], f[5]); w.w = pg8::cvt_pk_safe(f[6], f[7]); return __builtin_bit_cast(bf16x8, w); }
constexpr int SC_QP = 272, SC_VP = 80;
constexpr int SC_Q = 0, SC_K = 64 * SC_QP, SC_V = 2 * 64 * SC_QP, SC_S = SC_V + 64 * SC_VP, SC_SF = SC_S + 1280, SC_STAGE = SC_SF + 6144;
constexpr int SC_CIMG = 2 * SC_STAGE;
constexpr int SC_NIMG = SC_CIMG + 16384;
constexpr int SC_MC = SC_NIMG + 8192;
constexpr int SC_FL = SC_MC + 544;
static_assert(SC_FL + 4096 <= LDSCTL_OFF && SC_STAGE % 16 == 0, "scan LDS");
#define SF_BASE(tb) ((tb) == 0 ? 0 : (tb) == 1 ? 1 : (tb) == 2 ? 2 : 4)
#define SCHED_FENCE() __builtin_amdgcn_sched_barrier(0)
constexpr int FACW = 320;

__device__ __forceinline__ void scan_setup(const Ptrs& p, LAS unsigned char* lds, int item, int wid, int lane) {
    const int seq = item >> 3;
    const float* SB = WSP(float, WS_SCAL) + (size_t)seq * NCHUNK * 64; const float* SPM = SB + 2 * SCAL_ARR;
    if (wid == 0) {
        const float b63a = SB[(size_t)lane * 64 + 63], p63a = SPM[(size_t)lane * 64 + 63], b63b = SB[(size_t)64 * 64 + 63], p63b = SPM[(size_t)64 * 64 + 63];
        float m = 0.f;
        for (int c = 0; c < 65; ++c) {
            const int cl = c & 63;
            const float bb = (c < 64) ? __builtin_bit_cast(float, __builtin_amdgcn_readlane(__builtin_bit_cast(int, b63a), cl)) : b63b, pp = (c < 64) ? __builtin_bit_cast(float, __builtin_amdgcn_readlane(__builtin_bit_cast(int, p63a), cl)) : p63b;
            const float M63 = fmaxf(m, pp);
            if (lane == 0) { ((LAS float*)(lds + SC_MC))[c] = m; ((LAS float*)(lds + SC_MC))[68 + c] = M63; }
            m = bb + M63; }
    }
    __syncthreads();
}
__device__ __forceinline__ void scan_prepass(const Ptrs& p, LAS unsigned char* lds, int item, int wid, int lane) {
    using pg8::f32x4;
    const int seq = item >> 3, sl = item & 7, dir = seq & 1, h = (seq >> 1) & 3, b = seq >> 3, c16 = lane & 15, g = lane >> 4;
    const int c = 8 * wid + sl, nsteps = dir ? 64 : 65;
    const bool active = c < nsteps && !(dir == 0 && c == 0);
    bool first = true;
    {   const int cc = (dir == 0 && c == 0) ? 64 : c;
        const bool act = cc < nsteps;
        const float* SBq = WSP(float, WS_SCAL) + (size_t)seq * NCHUNK * 64; const float* SG = SBq + SCAL_ARR; const float* SPMq = SBq + 2 * SCAL_ARR;
        LAS float* Fl = (LAS float*)(lds + SC_FL + wid * 512);
        const bf16* QKM = WSP(bf16, WS_QKM);
        auto rowp = [&](int t) -> const bf16* { const int l = dir ? (LSEQ - 1 - 64 * cc - t) : (64 * cc + t - 48); return QKM + ((size_t)b * LSEQ + l) * 1024 + h * 256 + 8 * g; };
        v4u* SF = (v4u*)(p.ws + WS_SFRAG) + ((size_t)(seq * 64 + (dir ? cc : cc - 1)) * 6) * 64 + lane;
        bf16x8 qa[4][4], ka[4][4]; float sgv = 0.f, spmv = 0.f, sbv = 0.f;
        if (act) {
#pragma unroll
            for (int tb = 0; tb < 4; ++tb) { const bf16* qp = rowp(16 * tb + c16);
#pragma unroll
                for (int ks = 0; ks < 4; ++ks) { qa[tb][ks] = *(const GAS bf16x8*)(qp + 32 * ks); ka[tb][ks] = *(const GAS bf16x8*)(qp + 128 + 32 * ks); } }
            sgv = SG[(size_t)cc * 64 + lane]; spmv = SPMq[(size_t)cc * 64 + lane]; sbv = SBq[(size_t)cc * 64 + lane]; }
        if (first) { scan_setup(p, lds, item, wid, lane); first = false; }
        if (act) {
        { const float mc = ((const LAS float*)(lds + SC_MC))[cc], M63 = ((const LAS float*)(lds + SC_MC))[68 + cc];
          const float Mt = fmaxf(mc, spmv);
          const float Fv = __expf(sgv - M63), Rv = __expf(fminf(M63 - Mt, 80.f));
          Fl[lane] = Fv; Fl[64 + lane] = Rv;
          float* FAC = WSP(float, WS_FAC) + (size_t)(seq * 64 + (dir ? cc : cc - 1)) * FACW;
          FAC[lane] = Fv; FAC[64 + lane] = Rv; FAC[128 + lane] = __expf(mc - Mt); FAC[192 + lane] = __expf(-(sbv + Mt)); }
        LDS_WAIT(); asm volatile("" ::: "memory");
#pragma unroll
        for (int tb = 0; tb < 4; ++tb) {
            f32x4 X[4]; float rsum = 0.f;
#pragma unroll
            for (int sb = 0; sb <= tb; ++sb) {
                f32x4 x = (f32x4){0.f, 0.f, 0.f, 0.f};
#pragma unroll
                for (int ks = 0; ks < 4; ++ks) x = __builtin_amdgcn_mfma_f32_16x16x32_bf16(ka[sb][ks], qa[tb][ks], x, 0, 0, 0);
                const f32x4 F4 = *(const LAS f32x4*)(Fl + 16 * sb + 4 * g);
#pragma unroll
                for (int r = 0; r < 4; ++r) { float v = x[r]; if (sb == tb) v = (4 * g + r <= c16) ? v : 0.f; x[r] = v; rsum += v * F4[r]; }
                X[sb] = x; }
            rsum += __shfl_xor(rsum, 16); rsum += __shfl_xor(rsum, 32);
            if (g == 0) { float* FAC = WSP(float, WS_FAC) + (size_t)(seq * 64 + (dir ? cc : cc - 1)) * FACW; FAC[256 + 16 * tb + c16] = Fl[64 + 16 * tb + c16] * rsum; }
#pragma unroll
            for (int k2 = 0; 2 * k2 <= tb; ++k2) { float sf[8];
#pragma unroll
                for (int j = 0; j < 4; ++j) { sf[j] = X[2 * k2][j]; sf[4 + j] = (2 * k2 + 1 <= tb) ? X[(2 * k2 + 1 <= tb) ? 2 * k2 + 1 : 0][j] : 0.f; }
                SF[(SF_BASE(tb) + k2) * 64] = __builtin_bit_cast(v4u, pack8(sf)); }
        }
        LDS_WAIT(); asm volatile("" ::: "memory");
        }
    }
    (void)active;
}
struct ScanPre { v4u rq[4], rk[4], rv; };
__device__ __forceinline__ void scan_B_preload(const Ptrs& p, int item, int tid, ScanPre& o) {
    const int seq = item >> 3, sl = item & 7, dir = seq & 1, h = (seq >> 1) & 3, b = seq >> 3;
    const int qrow0 = (tid >> 4) & 15, qc = tid & 15, vrow = (tid >> 2) & 63, vpc = tid & 3;
    auto row_l0 = [&](int t) -> int { return dir ? (LSEQ - 1 - t) : (t - 48); };
    const bf16* QKM = WSP(bf16, WS_QKM); const bf16* XM = WSP(bf16, WS_XM);
#pragma unroll
    for (int i = 0; i < 4; ++i) { const int l = row_l0(qrow0 + 16 * i); o.rq[i] = (v4u){0, 0, 0, 0}; o.rk[i] = (v4u){0, 0, 0, 0};
        if (l >= 0) { const bf16* src = QKM + ((size_t)b * LSEQ + l) * 1024 + h * 256 + 8 * qc; o.rq[i] = *(const GAS v4u*)src; o.rk[i] = *(const GAS v4u*)(src + 128); } }
    o.rv = (v4u){0, 0, 0, 0};
    { const int l = row_l0(vrow); if (l >= 0) o.rv = *(const GAS v4u*)(XM + ((size_t)b * LSEQ + l) * 1024 + h * 256 + 32 * sl + 8 * vpc); }
}
__device__ __forceinline__ void scan_B(const Ptrs& p, LAS unsigned char* lds, int item, int tid, int wid, int lane, const ScanPre& pre0) {
    using pg8::f32x4;
    const int seq = item >> 3, sl = item & 7, dir = seq & 1, h = (seq >> 1) & 3, b = seq >> 3;
    const int nsteps = dir ? 64 : 65;
    const int c16 = lane & 15, g = lane >> 4;
    const float* SB = WSP(float, WS_SCAL) + (size_t)seq * NCHUNK * 64; const float* SG = SB + SCAL_ARR; const float* SPM = SG + SCAL_ARR;
    const int qrow0 = (tid >> 4) & 15, qc = tid & 15;
    const int vrow = (tid >> 2) & 63, vpc = tid & 3;
    const int farr = (tid >> 6) & 3, ft = tid & 63;
    const long long rstep = dir ? -64 : 64;
    auto row_l = [&](int c, int t) -> int { return dir ? (LSEQ - 1 - 64 * c - t) : (64 * c + t - 48); };
    const bf16* qkp; const bf16* vp;
    { const bf16* QKM = WSP(bf16, WS_QKM); const bf16* XM = WSP(bf16, WS_XM);
      qkp = QKM + ((size_t)b * LSEQ + row_l(1, qrow0)) * 1024 + h * 256 + 8 * qc;
      vp = XM + ((size_t)b * LSEQ + row_l(1, vrow)) * 1024 + h * 256 + 32 * sl + 8 * vpc; }
    const long long r16 = dir ? -16 * 1024 : 16 * 1024;
    v4u rq[4], rk[4], rv, rs0, rs1 = {0, 0, 0, 0}; float rx1 = 0.f, rx2 = 0.f, rfv = 0.f;
    const float* facb = WSP(float, WS_FAC) + ((size_t)seq * 64 - (dir ? 0 : 1)) * FACW;
    const v4u* sfp = (const v4u*)(p.ws + WS_SFRAG) + ((size_t)seq * 64 - (dir ? 0 : 1)) * 384 + tid;
    unsigned voq[4];
#pragma unroll
    for (int i = 0; i < 4; ++i) { const int t = qrow0 + 16 * i; voq[i] = (unsigned)((dir ? 63 - t : t) * 2048 + 16 * qc); }
    const unsigned vov = (unsigned)((dir ? 63 - vrow : vrow) * 2048 + 16 * vpc), vof = (unsigned)tid * 4u, vofv = (unsigned)vrow * 4u, vos = (unsigned)tid * 16u;
    auto issue = [&](int c) {
        const int lo = dir ? (LSEQ - 64 - 64 * c) : (64 * c - 48);
        const char* qb = (const char*)WSP(bf16, WS_QKM) + ((size_t)((size_t)b * LSEQ + lo) * 1024 + h * 256) * 2;
        const char* vb = (const char*)WSP(bf16, WS_XM) + ((size_t)((size_t)b * LSEQ + lo) * 1024 + h * 256 + 32 * sl) * 2;
        const char* fb = (const char*)(facb + (size_t)c * FACW);
        const char* sb = (const char*)(p.ws + WS_SFRAG) + ((size_t)seq * 64 - (dir ? 0 : 1) + c) * 6144;
#pragma unroll
        for (int i = 0; i < 4; ++i) { rq[i] = *(const GAS v4u*)(qb + voq[i]); rk[i] = *(const GAS v4u*)(qb + voq[i] + 256); }
        rv = *(const GAS v4u*)(vb + vov);
        rx1 = *(const GAS float*)(fb + vof); rfv = *(const GAS float*)(fb + vofv); if (tid >= 128 && tid < 192) rx2 = *(const GAS float*)(fb + vof + 512);
        rs0 = *(const GAS v4u*)(sb + vos); if (tid < 128) rs1 = *(const GAS v4u*)(sb + vos + 4096);
    };
    auto commit = [&](int c, int stage) {
        LAS unsigned char* S = lds + stage * SC_STAGE;
#pragma unroll
        for (int i = 0; i < 4; ++i) { const int t = qrow0 + 16 * i; *(LAS v4u*)(S + SC_Q + t * SC_QP + 16 * qc) = rq[i]; *(LAS v4u*)(S + SC_K + t * SC_QP + 16 * qc) = rk[i]; }
        { v4u fv;
          fv.x = pg8::cvt_pk_safe(bflo(rv.x) * rfv, bfhi(rv.x) * rfv); fv.y = pg8::cvt_pk_safe(bflo(rv.y) * rfv, bfhi(rv.y) * rfv); fv.z = pg8::cvt_pk_safe(bflo(rv.z) * rfv, bfhi(rv.z) * rfv); fv.w = pg8::cvt_pk_safe(bflo(rv.w) * rfv, bfhi(rv.w) * rfv);
          *(LAS v4u*)(S + SC_V + vrow * SC_VP + 16 * vpc) = fv; }
        *(LAS v4u*)(S + SC_SF + tid * 16) = rs0; if (tid < 128) *(LAS v4u*)(S + SC_SF + (256 + tid) * 16) = rs1;
        *(LAS float*)(S + SC_S + tid * 4) = rx1; if (tid >= 128 && tid < 192) *(LAS float*)(S + SC_S + (128 + tid) * 4) = rx2;
    };
    {
#pragma unroll
      for (int i = 0; i < 4; ++i) { rq[i] = pre0.rq[i]; rk[i] = pre0.rk[i]; }
      rv = pre0.rv;
      { const float x1 = (farr == 0 ? SG : SPM)[ft], x2 = (farr == 3) ? SB[ft] : 0.f;
        const float mc = ((const LAS float*)(lds + SC_MC))[0], M63 = ((const LAS float*)(lds + SC_MC))[68], Mt = fmaxf(mc, x1);
        if (farr == 0) rx1 = __expf(x1 - M63); else if (farr == 1) rx1 = __expf(fminf(M63 - Mt, 80.f)); else if (farr == 2) rx1 = __expf(mc - Mt); else rx1 = __expf(-(x2 + Mt));
        rfv = __expf(SG[vrow] - M63);
        if (dir && tid >= 128 && tid < 192) rx2 = facb[128 + tid]; }
      rs0 = (v4u){0, 0, 0, 0}; if (dir) { rs0 = *(const GAS v4u*)sfp; if (tid < 128) rs1 = *(const GAS v4u*)(sfp + 256); }
      commit(0, 0); }
    __syncthreads();
    f32x4 Cs[2][2], Ns[2];
#pragma unroll
    for (int i = 0; i < 2; ++i) { Ns[i] = (f32x4){0.f, 0.f, 0.f, 0.f}; Cs[0][i] = Ns[i]; Cs[1][i] = Ns[i]; }
    const int ktr_off = (8 * g + (c16 >> 2)) * SC_QP + 8 * (c16 & 3) + 32 * (2 * wid);
    const int vtr_off = ((c16 >> 2)) * SC_VP + 8 * (c16 & 3);
    for (int c = 0; c < nsteps; ++c) {
        const int st = c & 1;
        if (c + 1 < nsteps) issue(c + 1);
        const LAS unsigned char* S = lds + st * SC_STAGE;
        const LAS unsigned char* Ks = S + SC_K; const LAS unsigned char* Vs = S + SC_V;
        const LAS float* fF = (const LAS float*)(S + SC_S); const LAS float* fW = fF + 128;
        f32x4 gf[2][2]; s16x4 bvlo[2][2], bvhi[2][2], klo[2][2], khi[2][2];
#pragma unroll
        for (int ks = 0; ks < 2; ++ks) { gf[ks][0] = *(const LAS f32x4*)(fF + 32 * ks + 8 * g); gf[ks][1] = *(const LAS f32x4*)(fF + 32 * ks + 8 * g + 4); }
#pragma unroll
        for (int eb = 0; eb < 2; ++eb)
#pragma unroll
            for (int ks = 0; ks < 2; ++ks) { const LAS unsigned char* va = Vs + vtr_off + 32 * eb + (32 * ks + 8 * g) * SC_VP; bvlo[eb][ks] = ds_tr16(va); bvhi[eb][ks] = ds_tr16(va + 4 * SC_VP); }
#pragma unroll
        for (int d2 = 0; d2 < 2; ++d2)
#pragma unroll
            for (int ks = 0; ks < 2; ++ks) { const LAS unsigned char* ka = Ks + ktr_off + 32 * ks * SC_QP + 32 * d2; klo[d2][ks] = ds_tr16(ka); khi[d2][ks] = ds_tr16(ka + 4 * SC_QP); }
        const float decay = fW[63];
        SCHED_FENCE();
        bf16x8 Bf[2][2], Fb[2];
#pragma unroll
        for (int ks = 0; ks < 2; ++ks) { float ff[8];
#pragma unroll
            for (int j = 0; j < 4; ++j) { ff[j] = gf[ks][0][j]; ff[4 + j] = gf[ks][1][j]; }
            Fb[ks] = pack8(ff);
#pragma unroll
            for (int eb = 0; eb < 2; ++eb) Bf[eb][ks] = cat8(bvlo[eb][ks], bvhi[eb][ks]); }
#pragma unroll
        for (int d2 = 0; d2 < 2; ++d2) { Cs[0][d2] *= decay; Cs[1][d2] *= decay; Ns[d2] *= decay; }
#pragma unroll
        for (int ks = 0; ks < 2; ++ks)
#pragma unroll
            for (int d2 = 0; d2 < 2; ++d2) { const bf16x8 A = cat8(klo[d2][ks], khi[d2][ks]);
                Cs[0][d2] = __builtin_amdgcn_mfma_f32_16x16x32_bf16(A, Bf[0][ks], Cs[0][d2], 0, 0, 0);
                Cs[1][d2] = __builtin_amdgcn_mfma_f32_16x16x32_bf16(A, Bf[1][ks], Cs[1][d2], 0, 0, 0);
                Ns[d2] = __builtin_amdgcn_mfma_f32_16x16x32_bf16(A, Fb[ks], Ns[d2], 0, 0, 0); }
#pragma unroll
        for (int eb = 0; eb < 2; ++eb) { const float cfv[8] = {Cs[eb][0][0], Cs[eb][0][1], Cs[eb][0][2], Cs[eb][0][3], Cs[eb][1][0], Cs[eb][1][1], Cs[eb][1][2], Cs[eb][1][3]};
            *(LAS bf16x8*)(lds + SC_CIMG + (st ^ 1) * 8192 + (eb * 4 + wid) * 1024 + lane * 16) = pack8(cfv); }
        { const float nfv[8] = {Ns[0][0], Ns[0][1], Ns[0][2], Ns[0][3], Ns[1][0], Ns[1][1], Ns[1][2], Ns[1][3]};
          *(LAS bf16x8*)(lds + SC_NIMG + (st ^ 1) * 4096 + wid * 1024 + lane * 16) = pack8(nfv); }
        if (c + 1 < nsteps) commit(c + 1, st ^ 1);
        asm volatile("s_waitcnt lgkmcnt(0)" ::: "memory"); __builtin_amdgcn_s_barrier(); asm volatile("" ::: "memory");
    }
}
template <int TB>
__device__ __forceinline__ void scan_A(const Ptrs& p, LAS unsigned char* lds, int item, int lane) {
    using pg8::f32x4;
    const int seq = item >> 3, sl = item & 7, dir = seq & 1, h = (seq >> 1) & 3, b = seq >> 3;
    const int nsteps = dir ? 64 : 65;
    const int c16 = lane & 15, g = lane >> 4;
    auto row_l = [&](int c, int t) -> int { return dir ? (LSEQ - 1 - 64 * c - t) : (64 * c + t - 48); };
    __syncthreads();
    const int qrow_off = (16 * TB + c16) * SC_QP;
    const int vtr_off = ((c16 >> 2)) * SC_VP + 8 * (c16 & 3);
    bf16* hop = (dir ? WSP(bf16, WS_HB) : WSP(bf16, WS_HF)) + ((size_t)b * SEQ + (row_l(1, 16 * TB + c16) - NMETA)) * 1024 + h * 256 + 32 * sl + 4 * g;
    const long long rstep = dir ? -64 : 64;
    constexpr int NK2 = (TB >= 2) ? 2 : 1;
    for (int c = 0; c < nsteps; ++c) {
        const int st = c & 1;
        const LAS unsigned char* S = lds + st * SC_STAGE;
        const LAS unsigned char* Qs = S + SC_Q; const LAS unsigned char* Vs = S + SC_V;
        const LAS float* fF = (const LAS float*)(S + SC_S); const LAS float* fR = fF + 64; const LAS float* fW = fF + 128; const LAS float* fE = fF + 192; const LAS float* fQ = fF + 256;
        bf16x8 cf[2][4], nf[4], sfr[NK2]; v2u qlo[4], qhi[4]; s16x4 svlo[2][NK2], svhi[2][NK2];
#pragma unroll
        for (int kk = 0; kk < 4; ++kk) { cf[0][kk] = *(const LAS bf16x8*)(lds + SC_CIMG + st * 8192 + kk * 1024 + lane * 16); cf[1][kk] = *(const LAS bf16x8*)(lds + SC_CIMG + st * 8192 + (4 + kk) * 1024 + lane * 16);
            nf[kk] = *(const LAS bf16x8*)(lds + SC_NIMG + st * 4096 + kk * 1024 + lane * 16); }
#pragma unroll
        for (int kk = 0; kk < 4; ++kk) { qlo[kk] = *(const LAS v2u*)(Qs + qrow_off + 64 * kk + 8 * g); qhi[kk] = *(const LAS v2u*)(Qs + qrow_off + 64 * kk + 32 + 8 * g); }
#pragma unroll
        for (int k2 = 0; k2 < NK2; ++k2) sfr[k2] = *(const LAS bf16x8*)(S + SC_SF + (SF_BASE(TB) + k2) * 1024 + lane * 16);
#pragma unroll
        for (int eb = 0; eb < 2; ++eb)
#pragma unroll
            for (int k2 = 0; k2 < NK2; ++k2) { const LAS unsigned char* va = Vs + vtr_off + 32 * eb + (32 * k2 + 4 * g) * SC_VP; svlo[eb][k2] = ds_tr16(va); svhi[eb][k2] = ds_tr16(va + 16 * SC_VP); }
        const float Rt = fR[16 * TB + c16], Wt = fW[16 * TB + c16], Et = fE[16 * TB + c16], Qt = fQ[16 * TB + c16];
        SCHED_FENCE();
        f32x4 P0 = (f32x4){0.f, 0.f, 0.f, 0.f}, P1 = P0, Pn = P0, Sv0 = P0, Sv1 = P0;
#pragma unroll
        for (int kk = 0; kk < 4; ++kk) { const bf16x8 A = __builtin_bit_cast(bf16x8, (v4u){qlo[kk].x, qlo[kk].y, qhi[kk].x, qhi[kk].y});
            P0 = __builtin_amdgcn_mfma_f32_16x16x32_bf16(cf[0][kk], A, P0, 0, 0, 0); P1 = __builtin_amdgcn_mfma_f32_16x16x32_bf16(cf[1][kk], A, P1, 0, 0, 0);
            Pn = __builtin_amdgcn_mfma_f32_16x16x32_bf16(nf[kk], A, Pn, 0, 0, 0); }
#pragma unroll
        for (int k2 = 0; k2 < NK2; ++k2) {
            Sv0 = __builtin_amdgcn_mfma_f32_16x16x32_bf16(cat8(svlo[0][k2], svhi[0][k2]), sfr[k2], Sv0, 0, 0, 0);
            Sv1 = __builtin_amdgcn_mfma_f32_16x16x32_bf16(cat8(svlo[1][k2], svhi[1][k2]), sfr[k2], Sv1, 0, 0, 0); }
        if (!(dir == 0 && c == 0)) {
            bf16* op = hop + (long long)(c - 1) * rstep * 1024;
            const float den = Wt * Pn[0] + Qt, inv = __builtin_amdgcn_rcpf(fmaxf(fabsf(den), Et)), wi = Wt * inv, ri = Rt * inv;
            v2u o0, o1;
            o0.x = pg8::cvt_pk_safe(wi * P0[0] + ri * Sv0[0], wi * P0[1] + ri * Sv0[1]); o0.y = pg8::cvt_pk_safe(wi * P0[2] + ri * Sv0[2], wi * P0[3] + ri * Sv0[3]);
            o1.x = pg8::cvt_pk_safe(wi * P1[0] + ri * Sv1[0], wi * P1[1] + ri * Sv1[1]); o1.y = pg8::cvt_pk_safe(wi * P1[2] + ri * Sv1[2], wi * P1[3] + ri * Sv1[3]);
            *(GAS v2u*)op = o0; *(GAS v2u*)(op + 16) = o1; }
        asm volatile("s_waitcnt lgkmcnt(0)" ::: "memory"); __builtin_amdgcn_s_barrier(); asm volatile("" ::: "memory");
    }
}
__device__ __forceinline__ void scan_zero_images(LAS unsigned char* lds, int tid) { for (int i = tid; i < (16384 + 8192) / 4; i += NTHR) *(LAS unsigned*)(lds + SC_CIMG + i * 4) = 0u; }
__device__ __forceinline__ void scan_item(const Ptrs& p, LAS unsigned char* lds, int item, int tid, int wid, int lane, int flags, const ScanPre& pre0) {
    (void)flags;
    switch (wid) {
        case 0: case 1: case 2: case 3: scan_B(p, lds, item, tid, wid, lane, pre0); break;
        case 4: scan_A<0>(p, lds, item, lane); break;
        case 5: scan_A<1>(p, lds, item, lane); break;
        case 6: scan_A<2>(p, lds, item, lane); break;
        default: scan_A<3>(p, lds, item, lane); break;
    }
}

constexpr int NA_KR = 0, NA_VR = 65536, NA_KM = 131072, NA_VM = 133120, NA_RPB = 135168;
static_assert(NA_RPB + 4 * 15 * 32 * 4 <= LDSCTL_OFF, "NA LDS");
__device__ __forceinline__ int na_r0(int r) { return min(max(r - 4, 0), 56); }
__device__ __forceinline__ void na_block(const Ptrs& p, LAS unsigned char* lds, int item, int tid, int wave, int lane) {
    using pg8::f32x4;
    const int rb = item & 7, bh = item >> 3, h = bh & 7, b = bh >> 3;
    const int c16 = lane & 15, g = lane >> 4, seg = wave & 3, eh = wave >> 2;
    const bf16* QN = WSP(bf16, WS_QN); const bf16* KN = WSP(bf16, WS_KN); const bf16* VR = WSP(bf16, WS_VR); bf16* YB = WSP(bf16, WS_YB);
    const int st_r = tid >> 3, st_c = tid & 7;
    const int st_dst = st_r * 128 + ((st_c ^ ((st_r >> 1) & 7)) << 4);
    const bf16* ksrc = KN + ((size_t)b * LSEQ + NMETA + st_r) * NAI + h * 64 + 8 * st_c;
    const bf16* vsrc = VR + ((size_t)b * LSEQ + NMETA + st_r) * NAI + h * 64 + 8 * st_c;
    if (tid < 128) *(LAS v4u*)(lds + NA_KM + st_dst) = *(const GAS v4u*)(KN + ((size_t)b * LSEQ + st_r) * NAI + h * 64 + 8 * st_c);
    else if (tid < 256) { const int t2 = tid - 128; *(LAS v4u*)(lds + NA_VM + (t2 >> 3) * 128 + (((t2 & 7) ^ (((t2 >> 3) >> 1) & 7)) << 4)) = *(const GAS v4u*)(VR + ((size_t)b * LSEQ + (t2 >> 3)) * NAI + h * 64 + 8 * (t2 & 7)); }
    for (int i = tid; i < 4 * 15 * 32; i += NTHR) { const int s = i / 480, rem = i - s * 480, dr = rem >> 5, j = (rem & 31) + s;
        ((LAS float*)(lds + NA_RPB))[i] = (j < 31) ? p.rpb[h * 465 + dr * 31 + j] * 1.4426950408889634f : 0.f; }
    const int rfirst = 8 * rb, w0 = na_r0(rfirst);
#pragma unroll
    for (int half = 0; half < 2; ++half) {
        v4u kq[4], vq[4];
#pragma unroll
        for (int j = 0; j < 4; ++j) { const int kr = w0 + 4 * half + j; kq[j] = *(const GAS v4u*)(ksrc + (size_t)kr * 64 * NAI); vq[j] = *(const GAS v4u*)(vsrc + (size_t)kr * 64 * NAI); }
#pragma unroll
        for (int j = 0; j < 4; ++j) { const int sl = (w0 + 4 * half + j) & 7; *(LAS v4u*)(lds + NA_KR + sl * 8192 + st_dst) = kq[j]; *(LAS v4u*)(lds + NA_VR + sl * 8192 + st_dst) = vq[j]; }
    }
    __syncthreads();
    const int reg0 = min(max(16 * seg - 8, 0), 32);
    const int qcol = 16 * seg + c16, win0 = min(max(qcol - 8, 0), 48);
    const int dcb = reg0 + 4 * g - qcol + 15, bsh = dcb & 3;
    const LAS unsigned char* bias_base = lds + NA_RPB + (bsh * 480 + (dcb - bsh)) * 4;
    unsigned vmask = 0u;
#pragma unroll
    for (int ct = 0; ct < 2; ++ct)
#pragma unroll
        for (int q = 0; q < 4; ++q) { const int kcol = reg0 + 16 * ct + 4 * g + q; if (kcol >= win0 && kcol < win0 + 16) vmask |= 1u << (4 * ct + q); }
    float mb4[4];
#pragma unroll
    for (int q = 0; q < 4; ++q) mb4[q] = p.mbias[h * 16 + 4 * g + q] * 1.4426950408889634f;
    int koff[2][2];
#pragma unroll
    for (int ct = 0; ct < 2; ++ct)
#pragma unroll
        for (int ks = 0; ks < 2; ++ks) { const int tok = reg0 + 16 * ct + c16; koff[ct][ks] = tok * 128 + (((g + 4 * ks) ^ ((tok >> 1) & 7)) << 4); }
    int voff[2][2];
#pragma unroll
    for (int e2 = 0; e2 < 2; ++e2)
#pragma unroll
        for (int hl = 0; hl < 2; ++hl) { const int tok = reg0 + 16 * hl + 4 * g + (c16 >> 2), ch = 2 * (2 * eh + e2) + ((c16 & 3) >> 1); voff[e2][hl] = tok * 128 + ((ch ^ ((tok >> 1) & 7)) << 4) + 8 * (c16 & 1); }
    int vmoff[2];
#pragma unroll
    for (int e2 = 0; e2 < 2; ++e2) { const int tok = 4 * g + (c16 >> 2), ch = 2 * (2 * eh + e2) + ((c16 & 3) >> 1); vmoff[e2] = tok * 128 + ((ch ^ ((tok >> 1) & 7)) << 4) + 8 * (c16 & 1); }
    const int kmoff0 = c16 * 128 + ((g ^ ((c16 >> 1) & 7)) << 4), kmoff1 = c16 * 128 + (((g + 4) ^ ((c16 >> 1) & 7)) << 4);
    bf16x8 qn_[2];
    { const bf16* qp = QN + ((size_t)b * LSEQ + NMETA + rfirst * 64 + qcol) * NAI + h * 64 + 8 * g; qn_[0] = *(const GAS bf16x8*)qp; qn_[1] = *(const GAS bf16x8*)(qp + 32); }
    for (int rr8 = 0; rr8 < 8; ++rr8) {
        const int r = rfirst + rr8, r0 = na_r0(r);
        const bool have_new = (rr8 < 7) && (na_r0(r + 1) != r0);
        const int newrow = r0 + 8;
        v4u nk = {0, 0, 0, 0}, nv = {0, 0, 0, 0};
        if (have_new) { nk = *(const GAS v4u*)(ksrc + (size_t)newrow * 64 * NAI); nv = *(const GAS v4u*)(vsrc + (size_t)newrow * 64 * NAI); }
        const bf16x8 qf[2] = {qn_[0], qn_[1]};
        if (rr8 < 7) { const bf16* qp = QN + ((size_t)b * LSEQ + NMETA + (r + 1) * 64 + qcol) * NAI + h * 64 + 8 * g; qn_[0] = *(const GAS bf16x8*)qp; qn_[1] = *(const GAS bf16x8*)(qp + 32); }
        f32x4 X[17];
#pragma unroll
        for (int kr = 0; kr < 8; ++kr) { const LAS unsigned char* ks_ = lds + NA_KR + ((r0 + kr) & 7) * 8192;
#pragma unroll
            for (int ct = 0; ct < 2; ++ct) { const bf16x8 k0 = *(const LAS bf16x8*)(ks_ + koff[ct][0]), k1 = *(const LAS bf16x8*)(ks_ + koff[ct][1]);
                f32x4 x = __builtin_amdgcn_mfma_f32_16x16x32_bf16(k0, qf[0], (f32x4){0.f, 0.f, 0.f, 0.f}, 0, 0, 0);
                X[2 * kr + ct] = __builtin_amdgcn_mfma_f32_16x16x32_bf16(k1, qf[1], x, 0, 0, 0); } }
        { const bf16x8 k0 = *(const LAS bf16x8*)(lds + NA_KM + kmoff0), k1 = *(const LAS bf16x8*)(lds + NA_KM + kmoff1);
          f32x4 x = __builtin_amdgcn_mfma_f32_16x16x32_bf16(k0, qf[0], (f32x4){0.f, 0.f, 0.f, 0.f}, 0, 0, 0);
          X[16] = __builtin_amdgcn_mfma_f32_16x16x32_bf16(k1, qf[1], x, 0, 0, 0); }
        float mx = -INFINITY;
        const LAS unsigned char* brow = bias_base + (r0 - r + 7) * 128;
#pragma unroll
        for (int i = 0; i < 16; ++i) { const f32x4 bv = *(const LAS f32x4*)(brow + (i >> 1) * 128 + (i & 1) * 64);
#pragma unroll
            for (int q = 0; q < 4; ++q) { const float v = ((vmask >> (4 * (i & 1) + q)) & 1u) ? X[i][q] + bv[q] : -INFINITY; X[i][q] = v; mx = fmaxf(mx, v); } }
#pragma unroll
        for (int q = 0; q < 4; ++q) { const float v = X[16][q] + mb4[q]; X[16][q] = v; mx = fmaxf(mx, v); }
        mx = fmaxf(mx, __shfl_xor(mx, 16)); mx = fmaxf(mx, __shfl_xor(mx, 32));
        float sum = 0.f;
#pragma unroll
        for (int i = 0; i < 17; ++i)
#pragma unroll
            for (int q = 0; q < 4; ++q) { const float e = __builtin_amdgcn_exp2f(X[i][q] - mx); X[i][q] = e; sum += e; }
        sum += __shfl_xor(sum, 16); sum += __shfl_xor(sum, 32);
        const float inv = 1.0f / sum;
        f32x4 O[2] = {(f32x4){0.f, 0.f, 0.f, 0.f}, (f32x4){0.f, 0.f, 0.f, 0.f}};
#pragma unroll
        for (int kk = 0; kk < 8; ++kk) {
            float pf[8];
#pragma unroll
            for (int j = 0; j < 4; ++j) { pf[j] = X[2 * kk][j]; pf[4 + j] = X[2 * kk + 1][j]; }
            const bf16x8 A = pack8(pf);
            const LAS unsigned char* vs_ = lds + NA_VR + ((r0 + kk) & 7) * 8192;
#pragma unroll
            for (int e2 = 0; e2 < 2; ++e2) { const s16x4 lo = ds_tr16(vs_ + voff[e2][0]), hi = ds_tr16(vs_ + voff[e2][1]);
                O[e2] = __builtin_amdgcn_mfma_f32_16x16x32_bf16(A, cat8(lo, hi), O[e2], 0, 0, 0); } }
        { float pf[8];
#pragma unroll
          for (int j = 0; j < 4; ++j) { pf[j] = X[16][j]; pf[4 + j] = 0.f; }
          const bf16x8 A = pack8(pf);
#pragma unroll
          for (int e2 = 0; e2 < 2; ++e2) { const s16x4 lo = ds_tr16(lds + NA_VM + vmoff[e2]); const s16x4 z = {0, 0, 0, 0};
              O[e2] = __builtin_amdgcn_mfma_f32_16x16x32_bf16(A, cat8(lo, z), O[e2], 0, 0, 0); } }
#pragma unroll
        for (int q = 0; q < 4; ++q) { const float iv = __shfl(inv, 4 * g + q); bf16* op = YB + ((size_t)b * SEQ + r * 64 + 16 * seg + 4 * g + q) * NAI + h * 64 + 32 * eh + c16;
            op[0] = (bf16)f2bf(O[0][q] * iv); op[16] = (bf16)f2bf(O[1][q] * iv); }
        __syncthreads();
        if (have_new) { const int sl = newrow & 7; *(LAS v4u*)(lds + NA_KR + sl * 8192 + st_dst) = nk; *(LAS v4u*)(lds + NA_VR + sl * 8192 + st_dst) = nv; }
        __syncthreads();
    }
}

__device__ __forceinline__ void na_sync4(LAS unsigned* cnt, unsigned& epoch, int lane) {
    epoch += 4u;
    asm volatile("s_waitcnt lgkmcnt(0)" ::: "memory");
    if (lane == 0) __hip_atomic_fetch_add(cnt, 1u, __ATOMIC_RELAXED, __HIP_MEMORY_SCOPE_WORKGROUP);
    unsigned sp = 0;
    while ((unsigned)__builtin_amdgcn_readfirstlane((int)__hip_atomic_load(cnt, __ATOMIC_RELAXED, __HIP_MEMORY_SCOPE_WORKGROUP)) < epoch) { __builtin_amdgcn_s_sleep(0); if (++sp > (1u << 24)) break; }
    asm volatile("" ::: "memory");
}
__device__ __forceinline__ void na_block4(const Ptrs& p, LAS unsigned char* lds, int item, int tid4, int seg, int lane) {
    using pg8::f32x4;
    const int rb = item & 7, bh = item >> 3, h = bh & 7, b = bh >> 3;
    const int c16 = lane & 15, g = lane >> 4;
    LAS unsigned* cnt = (LAS unsigned*)(lds + MISC_OFF + 64); unsigned epoch = 0u;
    const bf16* QN = WSP(bf16, WS_QN); const bf16* KN = WSP(bf16, WS_KN); const bf16* VR = WSP(bf16, WS_VR); bf16* YB = WSP(bf16, WS_YB);
    const int st_r = tid4 >> 3, st_c = tid4 & 7;
    const int st_dst = st_r * 128 + ((st_c ^ ((st_r >> 1) & 7)) << 4), st_dst2 = (st_r + 32) * 128 + ((st_c ^ (((st_r + 32) >> 1) & 7)) << 4);
    const size_t st_2nd = (size_t)32 * NAI;
    const bf16* ksrc = KN + ((size_t)b * LSEQ + NMETA + st_r) * NAI + h * 64 + 8 * st_c;
    const bf16* vsrc = VR + ((size_t)b * LSEQ + NMETA + st_r) * NAI + h * 64 + 8 * st_c;
    if (tid4 < 128) *(LAS v4u*)(lds + NA_KM + st_dst) = *(const GAS v4u*)(KN + ((size_t)b * LSEQ + st_r) * NAI + h * 64 + 8 * st_c);
    { const int t2 = tid4 & 127; if (tid4 >= 128) *(LAS v4u*)(lds + NA_VM + (t2 >> 3) * 128 + (((t2 & 7) ^ (((t2 >> 3) >> 1) & 7)) << 4)) = *(const GAS v4u*)(VR + ((size_t)b * LSEQ + (t2 >> 3)) * NAI + h * 64 + 8 * (t2 & 7)); }
    for (int i = tid4; i < 4 * 15 * 32; i += 256) { const int s = i / 480, rem = i - s * 480, dr = rem >> 5, j = (rem & 31) + s;
        ((LAS float*)(lds + NA_RPB))[i] = (j < 31) ? p.rpb[h * 465 + dr * 31 + j] * 1.4426950408889634f : 0.f; }
    const int rfirst = 8 * rb, w0 = na_r0(rfirst);
    { v4u kq[8][2];
#pragma unroll
      for (int j = 0; j < 8; ++j) { const int kr = w0 + j; kq[j][0] = *(const GAS v4u*)(ksrc + (size_t)kr * 64 * NAI); kq[j][1] = *(const GAS v4u*)(ksrc + (size_t)kr * 64 * NAI + st_2nd); }
      __builtin_amdgcn_sched_barrier(0);
#pragma unroll
      for (int j = 0; j < 8; ++j) { const int sl = (w0 + j) & 7; *(LAS v4u*)(lds + NA_KR + sl * 8192 + st_dst) = kq[j][0]; *(LAS v4u*)(lds + NA_KR + sl * 8192 + st_dst2) = kq[j][1]; } }
    { v4u vq[8][2];
#pragma unroll
      for (int j = 0; j < 8; ++j) { const int kr = w0 + j; vq[j][0] = *(const GAS v4u*)(vsrc + (size_t)kr * 64 * NAI); vq[j][1] = *(const GAS v4u*)(vsrc + (size_t)kr * 64 * NAI + st_2nd); }
      __builtin_amdgcn_sched_barrier(0);
#pragma unroll
      for (int j = 0; j < 8; ++j) { const int sl = (w0 + j) & 7; *(LAS v4u*)(lds + NA_VR + sl * 8192 + st_dst) = vq[j][0]; *(LAS v4u*)(lds + NA_VR + sl * 8192 + st_dst2) = vq[j][1]; } }
    na_sync4(cnt, epoch, lane);
    const int reg0 = min(max(16 * seg - 8, 0), 32);
    const int qcol = 16 * seg + c16, win0 = min(max(qcol - 8, 0), 48);
    const int dcb = reg0 + 4 * g - qcol + 15, bsh = dcb & 3;
    const LAS unsigned char* bias_base = lds + NA_RPB + (bsh * 480 + (dcb - bsh)) * 4;
    unsigned vmask = 0u;
#pragma unroll
    for (int ct = 0; ct < 2; ++ct)
#pragma unroll
        for (int q = 0; q < 4; ++q) { const int kcol = reg0 + 16 * ct + 4 * g + q; if (kcol >= win0 && kcol < win0 + 16) vmask |= 1u << (4 * ct + q); }
    float mb4[4];
#pragma unroll
    for (int q = 0; q < 4; ++q) mb4[q] = p.mbias[h * 16 + 4 * g + q] * 1.4426950408889634f;
    int koff[2][2];
#pragma unroll
    for (int ct = 0; ct < 2; ++ct)
#pragma unroll
        for (int ks = 0; ks < 2; ++ks) { const int tok = reg0 + 16 * ct + c16; koff[ct][ks] = tok * 128 + (((g + 4 * ks) ^ ((tok >> 1) & 7)) << 4); }
    int voff[4][2];
#pragma unroll
    for (int e2 = 0; e2 < 4; ++e2)
#pragma unroll
        for (int hl = 0; hl < 2; ++hl) { const int tok = reg0 + 16 * hl + 4 * g + (c16 >> 2), ch = 2 * e2 + ((c16 & 3) >> 1); voff[e2][hl] = tok * 128 + ((ch ^ ((tok >> 1) & 7)) << 4) + 8 * (c16 & 1); }
    int vmoff[4];
#pragma unroll
    for (int e2 = 0; e2 < 4; ++e2) { const int tok = 4 * g + (c16 >> 2), ch = 2 * e2 + ((c16 & 3) >> 1); vmoff[e2] = tok * 128 + ((ch ^ ((tok >> 1) & 7)) << 4) + 8 * (c16 & 1); }
    const int kmoff0 = c16 * 128 + ((g ^ ((c16 >> 1) & 7)) << 4), kmoff1 = c16 * 128 + (((g + 4) ^ ((c16 >> 1) & 7)) << 4);
    bf16x8 qn_[2];
    { const bf16* qp = QN + ((size_t)b * LSEQ + NMETA + rfirst * 64 + qcol) * NAI + h * 64 + 8 * g; qn_[0] = *(const GAS bf16x8*)qp; qn_[1] = *(const GAS bf16x8*)(qp + 32); }
    for (int rr8 = 0; rr8 < 8; ++rr8) {
        const int r = rfirst + rr8, r0 = na_r0(r);
        const bool have_new = (rr8 < 7) && (na_r0(r + 1) != r0);
        const int newrow = r0 + 8;
        v4u nk = {0, 0, 0, 0}, nv = {0, 0, 0, 0}, nk2 = {0, 0, 0, 0}, nv2 = {0, 0, 0, 0};
        if (have_new) { nk = *(const GAS v4u*)(ksrc + (size_t)newrow * 64 * NAI); nv = *(const GAS v4u*)(vsrc + (size_t)newrow * 64 * NAI); nk2 = *(const GAS v4u*)(ksrc + (size_t)newrow * 64 * NAI + st_2nd); nv2 = *(const GAS v4u*)(vsrc + (size_t)newrow * 64 * NAI + st_2nd); }
        const bf16x8 qf[2] = {qn_[0], qn_[1]};
        if (rr8 < 7) { const bf16* qp = QN + ((size_t)b * LSEQ + NMETA + (r + 1) * 64 + qcol) * NAI + h * 64 + 8 * g; qn_[0] = *(const GAS bf16x8*)qp; qn_[1] = *(const GAS bf16x8*)(qp + 32); }
        f32x4 X[17];
        bf16x8 kfa[2][2][2], kfb[2][2][2];
        auto ldk = [&](bf16x8 (&kf)[2][2][2], int kp) {
#pragma unroll
            for (int k1 = 0; k1 < 2; ++k1) { const LAS unsigned char* ks_ = lds + NA_KR + ((r0 + 2 * kp + k1) & 7) * 8192;
#pragma unroll
                for (int ct = 0; ct < 2; ++ct) { kf[k1][ct][0] = *(const LAS bf16x8*)(ks_ + koff[ct][0]); kf[k1][ct][1] = *(const LAS bf16x8*)(ks_ + koff[ct][1]); } } };
        auto mmk = [&](const bf16x8 (&kf)[2][2][2], int kp) {
#pragma unroll
            for (int k1 = 0; k1 < 2; ++k1)
#pragma unroll
                for (int ct = 0; ct < 2; ++ct) { f32x4 x = __builtin_amdgcn_mfma_f32_16x16x32_bf16(kf[k1][ct][0], qf[0], (f32x4){0.f, 0.f, 0.f, 0.f}, 0, 0, 0);
                    X[2 * (2 * kp + k1) + ct] = __builtin_amdgcn_mfma_f32_16x16x32_bf16(kf[k1][ct][1], qf[1], x, 0, 0, 0); } };
        ldk(kfa, 0); __builtin_amdgcn_sched_barrier(0);
        ldk(kfb, 1); mmk(kfa, 0); __builtin_amdgcn_sched_barrier(0);
        ldk(kfa, 2); mmk(kfb, 1); __builtin_amdgcn_sched_barrier(0);
        ldk(kfb, 3); mmk(kfa, 2); __builtin_amdgcn_sched_barrier(0);
        const bf16x8 km0 = *(const LAS bf16x8*)(lds + NA_KM + kmoff0), km1 = *(const LAS bf16x8*)(lds + NA_KM + kmoff1);
        const LAS unsigned char* brow = bias_base + (r0 - r + 7) * 128;
        f32x4 bv16[16];
#pragma unroll
        for (int i = 0; i < 16; ++i) bv16[i] = *(const LAS f32x4*)(brow + (i >> 1) * 128 + (i & 1) * 64);
        s16x4 vla[2][4], vha[2][4], vlb[2][4], vhb[2][4];
        auto ldv = [&](s16x4 (&vl)[2][4], s16x4 (&vh)[2][4], int kp) {
#pragma unroll
            for (int k1 = 0; k1 < 2; ++k1) { const LAS unsigned char* vs_ = lds + NA_VR + ((r0 + 2 * kp + k1) & 7) * 8192;
#pragma unroll
                for (int e2 = 0; e2 < 4; ++e2) { vl[k1][e2] = ds_tr16(vs_ + voff[e2][0]); vh[k1][e2] = ds_tr16(vs_ + voff[e2][1]); } } };
        ldv(vla, vha, 0);
        mmk(kfb, 3);
        { f32x4 x = __builtin_amdgcn_mfma_f32_16x16x32_bf16(km0, qf[0], (f32x4){0.f, 0.f, 0.f, 0.f}, 0, 0, 0); X[16] = __builtin_amdgcn_mfma_f32_16x16x32_bf16(km1, qf[1], x, 0, 0, 0); }
        __builtin_amdgcn_sched_barrier(0);
        float mx = -INFINITY;
#pragma unroll
        for (int i = 0; i < 16; ++i) { const f32x4 bv = bv16[i];
#pragma unroll
            for (int q = 0; q < 4; ++q) { const float v = ((vmask >> (4 * (i & 1) + q)) & 1u) ? X[i][q] + bv[q] : -INFINITY; X[i][q] = v; mx = fmaxf(mx, v); } }
#pragma unroll
        for (int q = 0; q < 4; ++q) { const float v = X[16][q] + mb4[q]; X[16][q] = v; mx = fmaxf(mx, v); }
        mx = fmaxf(mx, __shfl_xor(mx, 16)); mx = fmaxf(mx, __shfl_xor(mx, 32));
        float sum = 0.f;
#pragma unroll
        for (int i = 0; i < 17; ++i)
#pragma unroll
            for (int q = 0; q < 4; ++q) { const float e = __builtin_amdgcn_exp2f(X[i][q] - mx); X[i][q] = e; sum += e; }
        sum += __shfl_xor(sum, 16); sum += __shfl_xor(sum, 32);
        const float inv = 1.0f / sum;
        f32x4 O[4] = {(f32x4){0.f, 0.f, 0.f, 0.f}, (f32x4){0.f, 0.f, 0.f, 0.f}, (f32x4){0.f, 0.f, 0.f, 0.f}, (f32x4){0.f, 0.f, 0.f, 0.f}};
        auto mmv = [&](const s16x4 (&vl)[2][4], const s16x4 (&vh)[2][4], int kp) {
#pragma unroll
            for (int k1 = 0; k1 < 2; ++k1) { const int kk = 2 * kp + k1; float pf[8];
#pragma unroll
                for (int j = 0; j < 4; ++j) { pf[j] = X[2 * kk][j]; pf[4 + j] = X[2 * kk + 1][j]; }
                const bf16x8 A = pack8(pf);
#pragma unroll
                for (int e2 = 0; e2 < 4; ++e2) O[e2] = __builtin_amdgcn_mfma_f32_16x16x32_bf16(cat8(vl[k1][e2], vh[k1][e2]), A, O[e2], 0, 0, 0); } };
        __builtin_amdgcn_sched_barrier(0);
        ldv(vlb, vhb, 1); mmv(vla, vha, 0); __builtin_amdgcn_sched_barrier(0);
        ldv(vla, vha, 2); mmv(vlb, vhb, 1); __builtin_amdgcn_sched_barrier(0);
        ldv(vlb, vhb, 3); mmv(vla, vha, 2); __builtin_amdgcn_sched_barrier(0);
        mmv(vlb, vhb, 3);
        { float pf[8];
#pragma unroll
          for (int j = 0; j < 4; ++j) { pf[j] = X[16][j]; pf[4 + j] = 0.f; }
          const bf16x8 A = pack8(pf);
#pragma unroll
          for (int e2 = 0; e2 < 4; ++e2) { const s16x4 lo = ds_tr16(lds + NA_VM + vmoff[e2]); const s16x4 z = {0, 0, 0, 0};
              O[e2] = __builtin_amdgcn_mfma_f32_16x16x32_bf16(cat8(lo, z), A, O[e2], 0, 0, 0); } }
        na_sync4(cnt, epoch, lane);
        if (have_new) { const int sl = newrow & 7; *(LAS v4u*)(lds + NA_KR + sl * 8192 + st_dst) = nk; *(LAS v4u*)(lds + NA_VR + sl * 8192 + st_dst) = nv;
            *(LAS v4u*)(lds + NA_KR + sl * 8192 + st_dst2) = nk2; *(LAS v4u*)(lds + NA_VR + sl * 8192 + st_dst2) = nv2; }
        na_sync4(cnt, epoch, lane);
        { bf16* op = YB + ((size_t)b * SEQ + r * 64 + qcol) * NAI + h * 64 + 4 * g;
#pragma unroll
          for (int e2 = 0; e2 < 4; ++e2) { v2u o; o.x = pg8::cvt_pk_safe(O[e2][0] * inv, O[e2][1] * inv); o.y = pg8::cvt_pk_safe(O[e2][2] * inv, O[e2][3] * inv); *(GAS v2u*)(op + 16 * e2) = o; } }
    }
}

__device__ __forceinline__ void p5_combine(const Ptrs& p, int gw, int NGW, int lane) {
    const bf16* XM = WSP(bf16, WS_XM); const bf16* SO = WSP(bf16, WS_SO); const bf16* HF = WSP(bf16, WS_HF); const bf16* HB = WSP(bf16, WS_HB); bf16* YA = WSP(bf16, WS_YA);
    float cw[3][16], cb[16]; load_conv_w(p, lane, cw, cb);
    float ng[16], sk[16];
#pragma unroll
    for (int q = 0; q < 4; ++q) { const f32x4 a = *(const GAS f32x4*)(p.mnorm_g + 16 * lane + 4 * q), s = *(const GAS f32x4*)(p.mskip + 16 * lane + 4 * q);
        ng[4 * q] = a.x; ng[4 * q + 1] = a.y; ng[4 * q + 2] = a.z; ng[4 * q + 3] = a.w; sk[4 * q] = s.x; sk[4 * q + 1] = s.y; sk[4 * q + 2] = s.z; sk[4 * q + 3] = s.w; }
    for (int tok = gw; tok < MTOK; tok += NGW) {
        const int b = tok >> 12, s = tok & 4095, l = s + NMETA;
        const size_t to = (size_t)tok * 1024 + 16 * lane, ro = ((size_t)b * LSEQ + l) * 1024 + 16 * lane;
        const v4u f0 = *(const GAS v4u*)(HF + to), f1 = *(const GAS v4u*)(HF + to + 8), b0 = *(const GAS v4u*)(HB + to), b1 = *(const GAS v4u*)(HB + to + 8);
        const v4u o0 = *(const GAS v4u*)(SO + ro), o1 = *(const GAS v4u*)(SO + ro + 8);
        float xc[16]; conv_silu16(XM, b, l, lane, cw, cb, xc);
        float hs[16]; float ss = 0.f;
#pragma unroll
        for (int e = 0; e < 4; ++e) { hs[2 * e] = bflo(f0[e]) + bflo(b0[e]); hs[2 * e + 1] = bfhi(f0[e]) + bfhi(b0[e]); hs[8 + 2 * e] = bflo(f1[e]) + bflo(b1[e]); hs[8 + 2 * e + 1] = bfhi(f1[e]) + bfhi(b1[e]); }
#pragma unroll
        for (int j = 0; j < 16; ++j) ss += hs[j] * hs[j];
        ss += __shfl_xor(ss, 1); ss += __shfl_xor(ss, 2); ss += __shfl_xor(ss, 4); ss += __shfl_xor(ss, 8);
        const float rs = 1.0f / sqrtf(ss * (1.f / 256.f) + EPS);
        float so[16];
#pragma unroll
        for (int e = 0; e < 4; ++e) { so[2 * e] = bflo(o0[e]); so[2 * e + 1] = bfhi(o0[e]); so[8 + 2 * e] = bflo(o1[e]); so[8 + 2 * e + 1] = bfhi(o1[e]); }
        float y[16];
#pragma unroll
        for (int j = 0; j < 16; ++j) y[j] = so[j] * (hs[j] * rs * ng[j] + sk[j] * xc[j]);
        v4u w0, w1; w0.x = pk2(y[0], y[1]); w0.y = pk2(y[2], y[3]); w0.z = pk2(y[4], y[5]); w0.w = pk2(y[6], y[7]); w1.x = pk2(y[8], y[9]); w1.y = pk2(y[10], y[11]); w1.z = pk2(y[12], y[13]); w1.w = pk2(y[14], y[15]);
        bf16* yo = YA + (size_t)(lane >> 5) * MTOK * 512 + (size_t)tok * 512 + 16 * (lane & 31);
        *(GAS v4u*)yo = w0; *(GAS v4u*)(yo + 8) = w1;
    }
}

constexpr int NPHASE = 10;
struct Args { Ptrs p; int ph_lo, ph_hi, li, flags; };
__global__ void __launch_bounds__(NTHR, 2) fwd_megakernel(Args args) {
    extern __shared__ __attribute__((aligned(16))) unsigned char lds_raw[];
    LAS unsigned char* lds = (LAS unsigned char*)lds_raw;
    const Ptrs& p = args.p;
    const int G = gridDim.x, bx = blockIdx.x;
    const int vcu = (G % 8 == 0) ? (bx % 8) * (G / 8) + bx / 8 : bx;
    const int NGW = G * NWAVES;
#define IDS() int tid = threadIdx.x; asm volatile("" : "+v"(tid)); const int lane = tid & 63, wave = __builtin_amdgcn_readfirstlane(tid >> 6), gw = vcu * NWAVES + wave; (void)lane; (void)gw
    for (int u = threadIdx.x; u < (LDS_BYTES - LDSCTL_OFF) / 4; u += NTHR) ((LAS unsigned*)(lds + LDSCTL_OFF))[u] = 0u;
    __syncthreads();
    const XcdBarrier bar = xcd_barrier_post((unsigned*)(p.ws + WS_CTL) + CW_BAR + args.li * XCD_BAR_WORDS, (volatile LAS unsigned*)(lds + MISC_OFF) + 8);
    const int lo = args.ph_lo, hi = args.ph_hi;
#define IN(k) (lo <= (k) && (k) < hi)
#define SEAM(k) do { if (IN(k) && IN((k) + 1)) xcd_barrier(bar); } while (0)
#define SEAM2(k, blk) do { if (IN(k) && IN((k) + 1)) { unsigned* const w_ = (unsigned*)(p.ws + WS_CTL) + 16384 + 1088 * (blk); sb_arrive(bar, w_); if (threadIdx.x == 0) sb_wait_lane0_early(bar, w_); __syncthreads(); } } while (0)

#ifdef MK_XBAR
    for (int i = 0; i < MK_XBAR; ++i) xcd_barrier(bar);
#endif
    unsigned* const sbw01 = (unsigned*)(p.ws + WS_CTL);
    if (IN(0)) { IDS(); p0_prologue<0>(p, lds, gw, NGW, wave, lane);
        if (IN(1)) sb_arrive(bar, sbw01, true);
        p0_prologue<1>(p, lds, gw, NGW, wave, lane);
        if (IN(1)) { if (threadIdx.x == 0) sb_wait_lane0_noinv(bar, sbw01); __syncthreads(); } }

    if (IN(1)) {
        pg8::Gemm g{WSP(bf16, WS_XN), WSP(bf16, WS_WIN), 1024, 1024, 1024, 0, nullptr, nullptr, 1 << 20}; pg8::StaticOrder S; S.init(RP, NIN, G, bx);
        EpiIn E{p.ws, p.out, p.qn_g, p.kn_g};
        pg8::gemm_phase<EpiIn, pg8::StaticOrder, true, true>(lds, g, S, E);
    } SEAM2(1, 1);


    if (IN(3)) {
        IDS(); pg8::StaticOrder S0; S0.init(MTOK, 1024, G, bx); pg8::Unit u0; bool has = S0.next(0, u0);
        auto pre = [&]() { if (!(args.flags & 8)) p3_pre(p, lds, vcu, gw, NGW, wave, lane); else __syncthreads(); };
        if (has && !(args.flags & 16)) p3_fused(p, lds, u0.pm, u0.pn, pre); else pre();
    } SEAM2(3, 2);

    if (IN(4)) {
        IDS();
        __syncthreads();
        scan_prepass(p, lds, vcu, wave, lane);
        { unsigned* const w_ = (unsigned*)(p.ws + WS_CTL) + 16384 + 1088 * 3; ScanPre pre0; sb_arrive(bar, w_); scan_zero_images(lds, tid); if (wave < 4) scan_B_preload(p, vcu, tid, pre0); if (threadIdx.x == 0) sb_wait_lane0_early(bar, w_); __syncthreads();
        if (!(args.flags & 2)) scan_item(p, lds, vcu, tid, wave, lane, args.flags, pre0); }
    }
    unsigned* const sbw45 = (unsigned*)(p.ws + WS_CTL) + 2240;
    if (IN(4) && IN(5)) sb_arrive(bar, sbw45);

    if (IN(5)) {
        IDS(); __syncthreads();
        const int role_idx = (wave & 1) + 2 * (wave >> 2);
        if (!(wave & 2)) { if (!(args.flags & 4)) na_block4(p, lds, vcu, role_idx * 64 + lane, role_idx, lane); }
        else {
            if (IN(4)) {
                LAS unsigned* flag = (LAS unsigned*)(lds + MISC_OFF + 96);
                if (wave == 2) { if (lane == 0) { sb_wait_lane0_early(bar, sbw45); __hip_atomic_store(flag, 1u, __ATOMIC_RELAXED, __HIP_MEMORY_SCOPE_WORKGROUP); } }
                unsigned sp = 0;
                while ((unsigned)__builtin_amdgcn_readfirstlane((int)__hip_atomic_load(flag, __ATOMIC_RELAXED, __HIP_MEMORY_SCOPE_WORKGROUP)) == 0u) { __builtin_amdgcn_s_sleep(1); if (++sp > (1u << 24)) break; }
                asm volatile("" ::: "memory");
            }
            p5_combine(p, vcu * 4 + role_idx, G * 4, lane);
        }
    } SEAM2(5, 4);

    if (IN(6)) {
        pg8::Gemm g{WSP(bf16, WS_YA), WSP(bf16, WS_WA), 1536, 512, 1536, 0, WSP(bf16, WS_YA) + (size_t)MTOK * 512, WSP(bf16, WS_YB), 8}; pg8::StaticOrder S; S.init(MTOK, 1024, G, bx);
        EpiMix E{WSP(bf16, WS_MIX), (const bf16*)p.out, (const bf16*)p.out + (size_t)MTOK * 1024};
        pg8::gemm_phase<EpiMix, pg8::StaticOrder, true, true>(lds, g, S, E);
    }
    unsigned* const sbw67 = (unsigned*)(p.ws + WS_CTL) + 1088;
    if (IN(6) && IN(7)) sb_arrive(bar, sbw67, true);

    if (IN(7)) {
        { IDS(); p_ffw<0>(p, lds, gw, NGW, wave, lane); }
        if (IN(6)) { if (threadIdx.x == 0) sb_wait_lane0_noinv(bar, sbw67); }
        __syncthreads();
        pg8::Gemm g{WSP(bf16, WS_MIX), WSP(bf16, WS_WOUT), 1024, 1024, 1024, 0, nullptr, nullptr, 1 << 20}; pg8::StaticOrder S; S.init(MTOK, 1024, G, bx);
        EpiOut E{p.x, p.out, WSP(bf16, WS_H2B), WSP(float, WS_ROWSS)};
        pg8::gemm_phase<EpiOut, pg8::StaticOrder, true, true>(lds, g, S, E);
    }
    unsigned* const sbw78 = (unsigned*)(p.ws + WS_CTL) + 16384;
    if (IN(7) && IN(8)) sb_arrive(bar, sbw78, true);

    if (IN(8)) {
        { IDS(); p_ffw<1>(p, lds, gw, NGW, wave, lane); }
        if (IN(7)) { if (threadIdx.x == 0) sb_wait_lane0_noinv(bar, sbw78); }
        __syncthreads();
        pg8::Gemm g{WSP(bf16, WS_H2B), WSP(bf16, WS_WFF1), 1024, 1024, 1024, 0, nullptr, nullptr, 1 << 20}; pg8::StaticOrder S; S.init(MTOK, DFF, G, bx);
        { IDS(); ff1_row_scales(WSP(float, WS_ROWSS), S, lds, tid); }
        EpiFF1 E{WSP(bf16, WS_HID), (const pg8::PG8_LAS_F*)(lds + RING_BYTES)};
        pg8::gemm_phase<EpiFF1, pg8::StaticOrder, true, true>(lds, g, S, E);
    } SEAM2(8, 5);

    if (IN(9)) {
        pg8::Gemm g{WSP(bf16, WS_HID), WSP(bf16, WS_WFF2), 4096, HIDP, HIDP, 0, nullptr, nullptr, 1 << 20}; pg8::StaticOrder S; S.init(MTOK, 1024, G, bx);
        EpiFF2 E{p.out, WSP(bf16, WS_H2B)};
        pg8::gemm_phase<EpiFF2, pg8::StaticOrder, true, true>(lds, g, S, E);
    }
#undef IN
#undef SEAM
}

extern "C" void kernel_launch(void* const* d_in, const int* in_sizes, int n_in, void* d_out, int out_size, void* d_ws, size_t ws_size, hipStream_t stream) {
    static int grid = 0;
    if (grid == 0) {
        if (n_in != 21 || in_sizes[0] != MTOK * DM || out_size != MTOK * DM || ws_size < WS_END) { fprintf(stderr, "kernel_launch: unexpected shapes (n_in %d, in0 %d, out %d, ws %zu); nothing launched\n", n_in, n_in > 0 ? in_sizes[0] : -1, out_size, ws_size); grid = -1; return; }
        int dev = 0, cus = 0, per_cu = 0;
        if (hipGetDevice(&dev) != hipSuccess || hipDeviceGetAttribute(&cus, hipDeviceAttributeMultiprocessorCount, dev) != hipSuccess) { grid = -1; return; }
        if (hipFuncSetAttribute((const void*)fwd_megakernel, hipFuncAttributeMaxDynamicSharedMemorySize, LDS_BYTES) != hipSuccess) { fprintf(stderr, "kernel_launch: hipFuncSetAttribute failed\n"); grid = -1; return; }
        if (hipOccupancyMaxActiveBlocksPerMultiprocessor(&per_cu, (const void*)fwd_megakernel, NTHR, LDS_BYTES) != hipSuccess || per_cu < 1) { fprintf(stderr, "kernel_launch: occupancy query reports %d workgroups per CU\n", per_cu); per_cu = 1; }
        (void)hipGetLastError();
        grid = cus;
    }
    if (grid < 0) return;
    if (hipMemsetAsync((char*)d_ws + WS_CTL, 0, CTL_ZERO_BYTES, stream) != hipSuccess) return;
    Args a{};
    const float** pp = (const float**)&a.p;
    for (int i = 0; i < 21; ++i) pp[i] = (const float*)d_in[i];
    a.p.out = (float*)d_out; a.p.ws = (unsigned char*)d_ws;
#ifndef MK_SUBFLAGS
#define MK_SUBFLAGS 0
#endif
#if defined(MK_DUP)
#ifndef MK_DUP_END
#define MK_DUP_END (MK_DUP + 1)
#endif
    const int cuts[4][2] = {{0, MK_DUP_END}, {MK_DUP, MK_DUP_END}, {MK_DUP_END, NPHASE}, {0, 0}};
    for (int li = 0; li < 3; ++li) { if (cuts[li][0] >= cuts[li][1]) continue; a.ph_lo = cuts[li][0]; a.ph_hi = cuts[li][1]; a.li = li; a.flags = (li == 1) ? (1 | MK_SUBFLAGS) : 0;
        hipLaunchKernelGGL(fwd_megakernel, dim3(grid), dim3(NTHR), LDS_BYTES, stream, a); }
#else
    a.ph_lo = 0; a.ph_hi = NPHASE; a.li = 0; a.flags = 0;
    hipLaunchKernelGGL(fwd_megakernel, dim3(grid), dim3(NTHR), LDS_BYTES, stream, a);
#endif
}
```
